# Optimizing an MI355X kernel written in HIP

```python
import math
import jax, jax.numpy as jnp
from jax import lax
import numpy as np

D_MODEL = 4096
BATCH = 1
SEQ = 16384
DEPTH = 4

N_MEM = 256
HEAD_DIM = 128
MEM_HEADS = 4
MEM_WIDTH = D_MODEL // 4
MEM_HEAD_DIM = MEM_WIDTH // MEM_HEADS
MIX_WIDTH = D_MODEL - MEM_WIDTH
DIFF_HEADS = MIX_WIDTH // (2 * HEAD_DIM)
FOX_HEADS = MIX_WIDTH // HEAD_DIM
ROT_DIM = HEAD_DIM // 4
ROPE_THETA = 500000.0
BLOCK_Q = 128
NORM_EPS = 1e-6
N_DIFF = (DEPTH + 1) // 2
N_FOX = DEPTH // 2
DIFF_IN = 4 * MIX_WIDTH + 2 * MEM_WIDTH
FOX_IN = 4 * MIX_WIDTH + FOX_HEADS + 2 * MEM_WIDTH

kernel_name = "hybrid_diff_fox_memory_trunk"


def rmsnorm(t, g):
    tf = t.astype(jnp.float32)
    y = tf * lax.rsqrt(jnp.mean(tf * tf, axis=-1, keepdims=True) + NORM_EPS)
    return (y * g.astype(jnp.float32)).astype(t.dtype)


def rope_tables(seq):
    inv = jnp.power(ROPE_THETA, -jnp.arange(0, ROT_DIM, 2, dtype=jnp.float32) / ROT_DIM)
    ang = jnp.arange(seq, dtype=jnp.float32)[:, None] * inv[None, :]
    return jnp.cos(ang), jnp.sin(ang)


def apply_partial_rope(t, cos, sin):
    s = t.shape[1]
    half = ROT_DIM // 2
    shp = (1, s) + (1,) * (t.ndim - 3) + (half,)
    c = cos.reshape(shp).astype(t.dtype)
    sn = sin.reshape(shp).astype(t.dtype)
    t1, t2, rest = t[..., :half], t[..., half:ROT_DIM], t[..., ROT_DIM:]
    return jnp.concatenate([t1 * c - t2 * sn, t2 * c + t1 * sn, rest], axis=-1)


def diff_attend(q, k, v, lam):
    b, s = q.shape[0], q.shape[1]
    nb = s // BLOCK_Q
    scale = HEAD_DIM ** -0.5
    kpos = jnp.arange(s)

    def one(i):
        st = i * BLOCK_Q
        qb = lax.dynamic_slice_in_dim(q, st, BLOCK_Q, axis=1)
        sc = jnp.einsum('bqchd,bkchd->bchqk', qb, k).astype(jnp.float32) * scale
        mask = (st + jnp.arange(BLOCK_Q))[:, None] >= kpos[None, :]
        p = jax.nn.softmax(jnp.where(mask, sc, -jnp.inf), axis=-1)
        a = p[:, 0] - lam * p[:, 1]
        return jnp.einsum('bhqk,bkhe->bqhe', a.astype(v.dtype), v)

    o = lax.map(one, jnp.arange(nb))
    return o.transpose(1, 0, 2, 3, 4).reshape(b, s, v.shape[2], v.shape[3])


def fox_attend(q, k, v, logf):
    b, s, h, d = q.shape
    nb = s // BLOCK_Q
    scale = HEAD_DIM ** -0.5
    c = jnp.cumsum(logf, axis=1).transpose(0, 2, 1)
    kpos = jnp.arange(s)

    def one(i):
        st = i * BLOCK_Q
        qb = lax.dynamic_slice_in_dim(q, st, BLOCK_Q, axis=1)
        cq = lax.dynamic_slice_in_dim(c, st, BLOCK_Q, axis=2)
        sc = jnp.einsum('bqhd,bkhd->bhqk', qb, k).astype(jnp.float32) * scale
        sc = sc + (cq[:, :, :, None] - c[:, :, None, :])
        mask = (st + jnp.arange(BLOCK_Q))[:, None] >= kpos[None, :]
        p = jax.nn.softmax(jnp.where(mask, sc, -jnp.inf), axis=-1)
        return jnp.einsum('bhqk,bkhd->bqhd', p.astype(v.dtype), v)

    o = lax.map(one, jnp.arange(nb))
    return o.transpose(1, 0, 2, 3, 4).reshape(b, s, h, d)


def diff_branch(h, w_in, q_g, k_g, lq1, lk1, lq2, lk2, sub_g, lam_init, cos, sin):
    b, s, _ = h.shape
    p = h @ w_in
    q, k, v, g, mq, mg = jnp.split(
        p, [MIX_WIDTH, 2 * MIX_WIDTH, 3 * MIX_WIDTH, 4 * MIX_WIDTH, 4 * MIX_WIDTH + MEM_WIDTH], axis=-1)
    q = apply_partial_rope(rmsnorm(q.reshape(b, s, 2, DIFF_HEADS, HEAD_DIM), q_g), cos, sin)
    k = apply_partial_rope(rmsnorm(k.reshape(b, s, 2, DIFF_HEADS, HEAD_DIM), k_g), cos, sin)
    v = v.reshape(b, s, DIFF_HEADS, 2 * HEAD_DIM)
    f32 = jnp.float32
    lam = (jnp.exp(jnp.sum(lq1.astype(f32) * lk1.astype(f32)))
           - jnp.exp(jnp.sum(lq2.astype(f32) * lk2.astype(f32))) + lam_init)
    o = diff_attend(q, k, v, lam)
    o = rmsnorm(o, sub_g) * (1.0 - lam_init)
    o = o.reshape(b, s, MIX_WIDTH) * jax.nn.silu(g)
    return o, mq, mg


def fox_branch(h, w_in, b_f, q_g, k_g):
    b, s, _ = h.shape
    p = h @ w_in
    q, k, v, g, fl, mq, mg = jnp.split(
        p, [MIX_WIDTH, 2 * MIX_WIDTH, 3 * MIX_WIDTH, 4 * MIX_WIDTH, 4 * MIX_WIDTH + FOX_HEADS,
            4 * MIX_WIDTH + FOX_HEADS + MEM_WIDTH], axis=-1)
    q = rmsnorm(q.reshape(b, s, FOX_HEADS, HEAD_DIM), q_g)
    k = rmsnorm(k.reshape(b, s, FOX_HEADS, HEAD_DIM), k_g)
    v = v.reshape(b, s, FOX_HEADS, HEAD_DIM)
    logf = jax.nn.log_sigmoid(fl.astype(jnp.float32) + b_f.astype(jnp.float32))
    o = fox_attend(q, k, v, logf).reshape(b, s, MIX_WIDTH)
    return o * jax.nn.silu(g), mq, mg


def mem_branch(mq, mg, kv, q_g, k_g):
    b, s, _ = mq.shape
    q = rmsnorm(mq.reshape(b, s, MEM_HEADS, MEM_HEAD_DIM), q_g)
    km, vm = jnp.split(kv, 2, axis=-1)
    km = rmsnorm(km.reshape(b, N_MEM, MEM_HEADS, MEM_HEAD_DIM), k_g)
    vm = vm.reshape(b, N_MEM, MEM_HEADS, MEM_HEAD_DIM)
    sc = jnp.einsum('bshd,bmhd->bhsm', q, km).astype(jnp.float32) * (MEM_HEAD_DIM ** -0.5)
    p = jax.nn.softmax(sc, axis=-1)
    o = jnp.einsum('bhsm,bmhd->bshd', p.astype(vm.dtype), vm).reshape(b, s, MEM_WIDTH)
    return o * jax.nn.silu(mg)


def setup_inputs(seed: int = 0) -> dict:
    key = jax.random.key(seed)
    ks = jax.random.split(key, 24)
    f32 = jnp.float32
    nrm = lambda k, shp, sc: jax.random.normal(k, shp, f32) * sc
    gain = lambda k, shp: 1.0 + 0.02 * jax.random.normal(k, shp, f32)
    ws = D_MODEL ** -0.5
    return {
        "x": nrm(ks[0], (BATCH, SEQ, D_MODEL), 1.0),
        "mem": nrm(ks[1], (BATCH, N_MEM, D_MODEL), 1.0),
        "mem_norm_g": gain(ks[2], (D_MODEL,)),
        "ln_g": gain(ks[3], (DEPTH, D_MODEL)),
        "w_out": nrm(ks[4], (DEPTH, D_MODEL, D_MODEL), ws),
        "w_mem_kv": nrm(ks[5], (DEPTH, D_MODEL, 2 * MEM_WIDTH), ws),
        "mem_q_norm_g": gain(ks[6], (DEPTH, MEM_HEAD_DIM)),
        "mem_k_norm_g": gain(ks[7], (DEPTH, MEM_HEAD_DIM)),
        "diff_w_in": nrm(ks[8], (N_DIFF, D_MODEL, DIFF_IN), ws),
        "diff_q_norm_g": gain(ks[9], (N_DIFF, HEAD_DIM)),
        "diff_k_norm_g": gain(ks[10], (N_DIFF, HEAD_DIM)),
        "diff_lam_q1": nrm(ks[11], (N_DIFF, HEAD_DIM), 0.1),
        "diff_lam_k1": nrm(ks[12], (N_DIFF, HEAD_DIM), 0.1),
        "diff_lam_q2": nrm(ks[13], (N_DIFF, HEAD_DIM), 0.1),
        "diff_lam_k2": nrm(ks[14], (N_DIFF, HEAD_DIM), 0.1),
        "diff_subln_g": gain(ks[15], (N_DIFF, 2 * HEAD_DIM)),
        "fox_w_in": nrm(ks[16], (N_FOX, D_MODEL, FOX_IN), ws),
        "fox_b_f": jax.random.uniform(ks[17], (N_FOX, FOX_HEADS), f32, 1.0, 5.0),
        "fox_q_norm_g": gain(ks[18], (N_FOX, HEAD_DIM)),
        "fox_k_norm_g": gain(ks[19], (N_FOX, HEAD_DIM)),
    }


def reference(x, mem, mem_norm_g, ln_g, w_out, w_mem_kv, mem_q_norm_g, mem_k_norm_g,
              diff_w_in, diff_q_norm_g, diff_k_norm_g, diff_lam_q1, diff_lam_k1,
              diff_lam_q2, diff_lam_k2, diff_subln_g,
              fox_w_in, fox_b_f, fox_q_norm_g, fox_k_norm_g):
    cos, sin = rope_tables(x.shape[1])
    mem_n = rmsnorm(mem, mem_norm_g)
    for i in range(DEPTH):
        h = rmsnorm(x, ln_g[i])
        j = i // 2
        if i % 2 == 0:
            lam_init = 0.8 - 0.6 * math.exp(-0.3 * i)
            mix, mq, mg = diff_branch(h, diff_w_in[j], diff_q_norm_g[j], diff_k_norm_g[j],
                                      diff_lam_q1[j], diff_lam_k1[j], diff_lam_q2[j],
                                      diff_lam_k2[j], diff_subln_g[j], lam_init, cos, sin)
        else:
            mix, mq, mg = fox_branch(h, fox_w_in[j], fox_b_f[j], fox_q_norm_g[j], fox_k_norm_g[j])
        kv = mem_n @ w_mem_kv[i]
        memo = mem_branch(mq, mg, kv, mem_q_norm_g[i], mem_k_norm_g[i])
        x = x + jnp.concatenate([mix, memo], axis=-1) @ w_out[i]
    return x
```

```cpp
#include <hip/hip_runtime.h>
#include <cstdio>
#include <cstdint>

#ifndef DUP_MASK
#define DUP_MASK 0x00
#endif
#ifndef MK_ONE_LAUNCH
#define MK_ONE_LAUNCH 1
#endif

#define GAS __attribute__((address_space(1)))
#define LAS __attribute__((address_space(3)))

constexpr int S_ = 16384, DM = 4096, DEPTH = 4, NMEM = 256;
constexpr int MIXW = 3072, MEMW = 1024, HD = 128;
constexpr int WROWS = 14592;
constexpr int LDP = 11264;
constexpr int QC = 0, KC = 3072, GC = 6144, MQC = 9216, MGC = 10240;
constexpr int V_PN0 = 24, V_PN1 = 36, FL_PN = 56;
constexpr int DIFF_IN = 14336, FOX_IN = 14360;
constexpr float NORM_EPS = 1e-6f;
constexpr float LOG2E = 1.4426950408889634f;
constexpr float QSCALE = 1.4426950408889634f * 0.08838834764831845f;

typedef unsigned short bf16;
typedef short bf16x8 __attribute__((ext_vector_type(8)));
typedef short s16x4 __attribute__((ext_vector_type(4)));
typedef float f32x16 __attribute__((ext_vector_type(16)));
typedef float f32x4 __attribute__((ext_vector_type(4)));
typedef float f32x2 __attribute__((ext_vector_type(2)));
typedef unsigned u32x4 __attribute__((ext_vector_type(4)));
typedef unsigned u32x2 __attribute__((ext_vector_type(2)));

constexpr size_t MiB = 1u << 20;
constexpr size_t al(size_t x) { return (x + MiB - 1) / MiB * MiB; }
constexpr size_t WS_CTL = 0, CTL_ZERO_BYTES = 1 * MiB;
constexpr size_t SZ_WIN = (size_t)WROWS * DM * 2;
constexpr size_t WS_WIN = 1 * MiB;
constexpr size_t WS_WOUT = WS_WIN + al(4 * SZ_WIN);
constexpr size_t WS_WKV = WS_WOUT + 4 * (size_t)DM * DM * 2;
constexpr size_t WS_MEMN = WS_WKV + 4 * (size_t)2048 * DM * 2;
constexpr size_t WS_KV = WS_MEMN + (size_t)NMEM * DM * 2;
constexpr size_t WS_KMQ = WS_KV + (size_t)NMEM * 8192 * 4;
constexpr size_t WS_VMT = WS_KMQ + (size_t)16 * 256 * 256 * 2;
constexpr size_t WS_ROPE = WS_VMT + (size_t)16 * 256 * 256 * 2;
constexpr size_t WS_H = WS_ROPE + (size_t)S_ * 32 * 4;
constexpr size_t WS_P = WS_H + (size_t)S_ * DM * 2;
constexpr size_t WS_A = WS_P + al((size_t)S_ * LDP * 2);
constexpr size_t WS_DK = WS_A + (size_t)S_ * DM * 2;
constexpr size_t WS_FL = WS_DK + al((size_t)24 * S_ * 4);
constexpr size_t WS_OP = WS_FL + (size_t)S_ * 32 * 4;
constexpr size_t WS_VT = WS_OP + (size_t)2 * S_ * MIXW * 4;
constexpr size_t WS_SSQP = WS_VT + (size_t)MIXW * S_ * 2;
constexpr size_t WS_END = WS_SSQP + (size_t)DEPTH * S_ * 16 * 4;
constexpr int CW_BAR = 4096;
constexpr int CW_QUAD = 8192 + 4096;
constexpr int CW_QCTR = 8192;
constexpr size_t WS_JLO = WS_CTL + 128 * 1024;
constexpr size_t WS_SSQ = WS_CTL + 256 * 1024;

constexpr int RING_BYTES = 131072;
constexpr int LDS_BYTES = 155648;
constexpr int LDSCTL_OFF = LDS_BYTES - 512, MISC_OFF = LDSCTL_OFF + 320;

#define LDS_WAIT() asm volatile("s_waitcnt lgkmcnt(0)" ::: "memory")
#define VM_WAIT() asm volatile("s_waitcnt vmcnt(0)" ::: "memory")
__device__ __forceinline__ unsigned cvt_pk_bf16(float lo, float hi) { unsigned r; asm volatile("v_cvt_pk_bf16_f32 %0, %1, %2" : "=v"(r) : "v"(lo), "v"(hi)); return r; }
__device__ __forceinline__ float bf2f(unsigned short b) { return __uint_as_float(((unsigned)b) << 16); }
__device__ __forceinline__ float bflo(unsigned w) { return __uint_as_float(w << 16); }
__device__ __forceinline__ float bfhi(unsigned w) { return __uint_as_float(w & 0xffff0000u); }
__device__ __forceinline__ float shx(float v, int mask, int lane) { return __int_as_float(__builtin_amdgcn_ds_bpermute((lane ^ mask) << 2, __float_as_int(v))); }
__device__ __forceinline__ float shidx(float v, int src) { return __int_as_float(__builtin_amdgcn_ds_bpermute(src << 2, __float_as_int(v))); }
__device__ __forceinline__ float half_sum(float v) { auto rr = __builtin_amdgcn_permlane32_swap(__float_as_uint(v), __float_as_uint(v), false, false); return __uint_as_float(rr[0]) + __uint_as_float(rr[1]); }
__device__ __forceinline__ float half_max(float v) { auto rr = __builtin_amdgcn_permlane32_swap(__float_as_uint(v), __float_as_uint(v), false, false); return fmaxf(__uint_as_float(rr[0]), __uint_as_float(rr[1])); }
__device__ __forceinline__ float wave_sum(float v, int lane) {
#pragma unroll
    for (int o = 1; o < 32; o <<= 1) v += shx(v, o, lane);
    return half_sum(v);
}
__device__ __forceinline__ float silu_f(float x) { return x * __builtin_amdgcn_rcpf(1.f + __builtin_amdgcn_exp2f(-x * LOG2E)); }

namespace pg8 {
typedef unsigned short bf16_t;
constexpr int BM = 256, BK = 64, HALF = 128, HTB = HALF * BK * 2, STAGE_BYTES = 8 * HTB, NXCD = 8, WGM = 8;
__host__ __device__ __forceinline__ int lds_byte(int r, int c) { const int st = (r >> 4) * 2 + (c >> 5), rr = r & 15, cc = c & 31, ob = rr * 64 + cc * 2; return st * 1024 + (ob ^ (((ob >> 9) & 1) << 5)); }
__host__ __device__ __forceinline__ void stage_rc(int b, int& R, int& C) { const int st = b / 1024, sb = b % 1024, swz = sb ^ (((sb >> 9) & 1) << 5); R = (st >> 1) * 16 + swz / 64; C = (st & 1) * 32 + (swz % 64) / 2; }
__host__ __device__ __forceinline__ int perm32(int rho) { const int n = rho >> 4, i = rho & 15; return 8 * (i >> 2) + 4 * n + (i & 3); }
struct Unit { int pm, pn; };
struct Gemm { const bf16_t* A; const bf16_t* Bt; int M, N, K; int ld; };
struct StaticOrder {
    int nM, nN, nwg, G, c;
    __host__ __device__ void init(int M, int N, int G_, int c_) { nM = M / BM; nN = N / BM; nwg = nM * nN; G = G_; c = c_; }
    __host__ __device__ bool next(int i, Unit& u) const {
        const long L = (long)i * G + c; if (L >= nwg) return false;
        int wgid = (int)L; { const int q = nwg / NXCD, r = nwg % NXCD, xcd = wgid % NXCD, off = wgid / NXCD; wgid = (xcd < r ? xcd * (q + 1) : r * (q + 1) + (xcd - r) * q) + off; }
        const int nig = WGM * nN, gid = wgid / nig, fm = gid * WGM, gsz = (nM - fm) < WGM ? (nM - fm) : WGM;
        u.pm = fm + ((wgid % nig) % gsz); u.pn = (wgid % nig) / gsz; return true;
    }
    __device__ __forceinline__ void a_ready(const Unit&) const {}
    __device__ __forceinline__ void done(const Unit&) const {}
    __device__ __forceinline__ size_t offA(const Unit& u, size_t tstep) const { return (size_t)u.pm * tstep; }
    __device__ __forceinline__ size_t offB(const Unit& u, size_t tstep) const { return (size_t)u.pn * tstep; }
};
struct SplitKOrder {
    int nS, nN, G, c, K;
    __device__ void init(int nS_, int N, int K_, int G_, int c_) { nS = nS_; nN = N / BM; K = K_; G = G_; c = c_; }
    __device__ bool next(int i, Unit& u) const { const int L = i * G + c; if (L >= nS * nN) return false; u.pm = L % nS; u.pn = L / nS; return true; }
    __device__ __forceinline__ void a_ready(const Unit&) const {}
    __device__ __forceinline__ void done(const Unit&) const {}
    __device__ __forceinline__ size_t offA(const Unit& u, size_t) const { return (size_t)u.pm * K * 2; }
    __device__ __forceinline__ size_t offB(const Unit& u, size_t tstep) const { return (size_t)u.pn * tstep + (size_t)u.pm * K * 2; }
};
struct InprojOrder : StaticOrder {
    long dBA; int v0, v1;
    __device__ __forceinline__ size_t offA(const Unit& u, size_t tstep) const { return (u.pn >= v0 && u.pn < v1) ? (size_t)(dBA + (long)((size_t)u.pn * tstep)) : (size_t)u.pm * tstep; }
    __device__ __forceinline__ size_t offB(const Unit& u, size_t tstep) const { return (u.pn >= v0 && u.pn < v1) ? (size_t)(-dBA + (long)((size_t)u.pm * tstep)) : (size_t)u.pn * tstep; }
};
struct EpiP {
    static constexpr bool PERM = true, AFTER_DRAIN = false;
    bf16_t* O; int ldc; float* fl; int fl_pn; const float* ssq;
    LAS float* tab; const float* qg; const float* kg; const float* rope; int do_rope; bf16_t* vt; const LAS float* rtab;
    __device__ __forceinline__ void operator()(const f32x4 (&acc)[2][2][4][2], const Unit& u, int wr, int wc, int fr, int fq) const {
        if (u.pn >= V_PN0 && u.pn < V_PN1) {
            const int vr0 = (u.pn - V_PN0) * BM + wr * 64 + fr, t0 = wc * 32 + 8 * fq;
            f32x4 ra[2], rb[2];
#pragma unroll
            for (int bj = 0; bj < 2; ++bj) { ra[bj] = *(const LAS f32x4*)(rtab + t0 + bj * HALF); rb[bj] = *(const LAS f32x4*)(rtab + t0 + bj * HALF + 4); }
#pragma unroll
            for (int ai = 0; ai < 2; ++ai)
#pragma unroll
                for (int m = 0; m < 4; ++m) {
                    bf16_t* rp = vt + (size_t)(vr0 + ai * HALF + m * 16) * S_ + (size_t)u.pm * BM + wc * 32 + 16 * (fq & 1) + 4 * (fq >> 1);
#pragma unroll
                    for (int bj = 0; bj < 2; ++bj) { const f32x4 v0 = acc[ai][bj][m][0] * ra[bj], v1 = acc[ai][bj][m][1] * rb[bj];
                        u32x2 w0, w1; w0.x = cvt_pk_bf16(v0[0], v0[1]); w0.y = cvt_pk_bf16(v0[2], v0[3]); w1.x = cvt_pk_bf16(v1[0], v1[1]); w1.y = cvt_pk_bf16(v1[2], v1[3]);
                        *(u32x2*)(rp + bj * HALF) = w0; *(u32x2*)(rp + bj * HALF + 8) = w1; } }
            return;
        }
        const int row0 = u.pm * BM + wr * 64 + fr;
        float rs[2][4];
#pragma unroll
        for (int ai = 0; ai < 2; ++ai)
#pragma unroll
            for (int m = 0; m < 4; ++m) rs[ai][m] = rtab[wr * 64 + fr + ai * HALF + m * 16];
        if (u.pn == fl_pn) {
            if (wc == 0) {
#pragma unroll
                for (int ai = 0; ai < 2; ++ai)
#pragma unroll
                    for (int m = 0; m < 4; ++m) { float* rp = fl + (size_t)(row0 + ai * HALF + m * 16) * 32 + 8 * fq;
                        *(f32x4*)(rp) = acc[ai][0][m][0] * rs[ai][m]; *(f32x4*)(rp + 4) = acc[ai][0][m][1] * rs[ai][m]; }
            }
            return;
        }
        const int col0 = u.pn * BM + wc * 32 + 8 * fq;
        if (u.pn < 24) {
            const int lane = fq * 16 + fr; const bool isq = u.pn < 12;
            int frq = fr; asm volatile("" : "+v"(frq));
            const float* gp = (isq ? qg : kg) + wc * 32 + 8 * fq;
            const f32x4 g0 = *(const f32x4*)gp, g1 = *(const f32x4*)(gp + 4);
#pragma unroll
            for (int ai = 0; ai < 2; ++ai)
#pragma unroll
                for (int m = 0; m < 4; ++m)
#pragma unroll
                    for (int bj = 0; bj < 2; ++bj) { const f32x4 a = acc[ai][bj][m][0] * rs[ai][m], b = acc[ai][bj][m][1] * rs[ai][m];
                        float sp = ((a[0] * a[0] + a[1] * a[1]) + (a[2] * a[2] + a[3] * a[3])) + ((b[0] * b[0] + b[1] * b[1]) + (b[2] * b[2] + b[3] * b[3]));
                        sp += shx(sp, 16, lane); sp = half_sum(sp);
                        if (fq == 0) tab[((((ai * 2 + wr) * 64 + m * 16 + frq) * 2 + bj) * 4) + wc] = sp; }
            asm volatile("s_waitcnt lgkmcnt(0)" ::: "memory"); __builtin_amdgcn_s_barrier(); asm volatile("" ::: "memory");
            const float hs = isq ? QSCALE : 1.f;
#pragma unroll
            for (int ai = 0; ai < 2; ++ai)
#pragma unroll
                for (int m = 0; m < 4; ++m) { const int row = row0 + ai * HALF + m * 16; bf16_t* rowp = O + (size_t)row * ldc + col0;
                    f32x4 y0[2], y1[2];
#pragma unroll
                    for (int bj = 0; bj < 2; ++bj) { const f32x4 t = *(const LAS f32x4*)(tab + ((((ai * 2 + wr) * 64 + m * 16 + fr) * 2 + bj) * 4));
                        const float rh = __builtin_amdgcn_rsqf(((t[0] + t[1]) + (t[2] + t[3])) * (1.f / 128.f) + NORM_EPS) * hs * rs[ai][m];
                        y0[bj] = acc[ai][bj][m][0] * rh * g0; y1[bj] = acc[ai][bj][m][1] * rh * g1; }
                    if (do_rope && wc == 0) {
                        const float* rp = rope + (size_t)row * 32 + 8 * (fq & 1);
                        const f32x4 c0 = *(const f32x4*)rp, c1 = *(const f32x4*)(rp + 4), s0 = *(const f32x4*)(rp + 16), s1 = *(const f32x4*)(rp + 20);
                        const float sgn = (fq & 2) ? 1.f : -1.f;
#pragma unroll
                        for (int bj = 0; bj < 2; ++bj)
#pragma unroll
                            for (int e = 0; e < 4; ++e) {
                                { auto rr = __builtin_amdgcn_permlane32_swap(__float_as_uint(y0[bj][e]), __float_as_uint(y0[bj][e]), false, false);
                                  const float oth = __uint_as_float((fq & 2) ? rr[0] : rr[1]); y0[bj][e] = y0[bj][e] * c0[e] + sgn * oth * s0[e]; }
                                { auto rr = __builtin_amdgcn_permlane32_swap(__float_as_uint(y1[bj][e]), __float_as_uint(y1[bj][e]), false, false);
                                  const float oth = __uint_as_float((fq & 2) ? rr[0] : rr[1]); y1[bj][e] = y1[bj][e] * c1[e] + sgn * oth * s1[e]; } }
                    }
#pragma unroll
                    for (int bj = 0; bj < 2; ++bj) { u32x4 w; w.x = cvt_pk_bf16(y0[bj][0], y0[bj][1]); w.y = cvt_pk_bf16(y0[bj][2], y0[bj][3]); w.z = cvt_pk_bf16(y1[bj][0], y1[bj][1]); w.w = cvt_pk_bf16(y1[bj][2], y1[bj][3]);
                        *(u32x4*)(rowp + bj * HALF) = w; } }
            return;
        }
        const int colp = col0 - (V_PN1 - V_PN0) * BM;
#pragma unroll
        for (int ai = 0; ai < 2; ++ai)
#pragma unroll
            for (int m = 0; m < 4; ++m) { bf16_t* rowp = O + (size_t)(row0 + ai * HALF + m * 16) * ldc + colp;
#pragma unroll
                for (int bj = 0; bj < 2; ++bj) { const f32x4 v0 = acc[ai][bj][m][0] * rs[ai][m], v1 = acc[ai][bj][m][1] * rs[ai][m];
                    u32x4 w; w.x = cvt_pk_bf16(v0[0], v0[1]); w.y = cvt_pk_bf16(v0[2], v0[3]); w.z = cvt_pk_bf16(v1[0], v1[1]); w.w = cvt_pk_bf16(v1[2], v1[3]);
                    *(u32x4*)(rowp + bj * HALF) = w; } }
    }
};
struct EpiF32 {
    static constexpr bool PERM = false, AFTER_DRAIN = false;
    float* C; int ldc;
    __device__ __forceinline__ void operator()(const f32x4 (&acc)[2][2][4][2], const Unit& u, int wr, int wc, int fr, int fq) const {
        const int row0 = u.pm * BM + wr * 64 + fr, col0 = u.pn * BM + wc * 32 + 4 * fq;
#pragma unroll
        for (int ai = 0; ai < 2; ++ai)
#pragma unroll
            for (int m = 0; m < 4; ++m) { float* rowp = C + (size_t)(row0 + ai * HALF + m * 16) * ldc + col0;
#pragma unroll
                for (int bj = 0; bj < 2; ++bj)
#pragma unroll
                    for (int n = 0; n < 2; ++n) *(f32x4*)(rowp + bj * HALF + n * 16) = acc[ai][bj][m][n]; }
    }
};
struct EpiRes {
    static constexpr bool PERM = true, AFTER_DRAIN = false;
    const float* xin_f; const bf16_t* xin_b; float* out; int ldc; bf16_t* xb; float* ssq; LAS float* tab;
    __device__ __forceinline__ void operator()(const f32x4 (&acc)[2][2][4][2], const Unit& u, int wr, int wc, int fr, int fq) const {
        const int row0 = u.pm * BM + wr * 64 + fr, col0 = u.pn * BM + wc * 32 + 8 * fq;
        const int lane = fq * 16 + fr;
        auto finish = [&](int g, const f32x4 (&xi)[4]) {
            const int ai = g >> 2, m = g & 3; const int row = row0 + ai * HALF + m * 16; const size_t off = (size_t)row * ldc + col0;
            float sq = 0.f;
#pragma unroll
            for (int bj = 0; bj < 2; ++bj) { const f32x4 y0 = xi[bj * 2] + acc[ai][bj][m][0], y1 = xi[bj * 2 + 1] + acc[ai][bj][m][1];
                if (out) { *(f32x4*)(out + off + bj * HALF) = y0; *(f32x4*)(out + off + bj * HALF + 4) = y1; }
                if (xb) { u32x4 w; w.x = cvt_pk_bf16(y0[0], y0[1]); w.y = cvt_pk_bf16(y0[2], y0[3]); w.z = cvt_pk_bf16(y1[0], y1[1]); w.w = cvt_pk_bf16(y1[2], y1[3]); *(u32x4*)(xb + off + bj * HALF) = w;
                          sq += ((y0[0] * y0[0] + y0[1] * y0[1]) + (y0[2] * y0[2] + y0[3] * y0[3])) + ((y1[0] * y1[0] + y1[1] * y1[1]) + (y1[2] * y1[2] + y1[3] * y1[3])); } }
            if (xb) { sq += shx(sq, 16, lane); sq = half_sum(sq);
                      if (fq == 0) tab[((ai * 2 + wr) * 64 + m * 16 + fr) * 4 + wc] = sq; } };
        if (xin_f) {
            f32x4 ra[4], rb[4];
            auto ld = [&](int g, f32x4 (&r)[4]) { const size_t off = (size_t)(row0 + (g >> 2) * HALF + (g & 3) * 16) * ldc + col0;
#pragma unroll
                for (int q = 0; q < 4; ++q) r[q] = *(const f32x4*)(xin_f + off + (q >> 1) * HALF + (q & 1) * 4); };
            ld(0, ra);
#pragma unroll
            for (int g = 0; g < 8; g += 2) {
                ld(g + 1, rb); __builtin_amdgcn_sched_barrier(0); finish(g, ra); __builtin_amdgcn_sched_barrier(0);
                if (g + 2 < 8) ld(g + 2, ra); __builtin_amdgcn_sched_barrier(0); finish(g + 1, rb); __builtin_amdgcn_sched_barrier(0); }
        } else {
            u32x4 ra[2], rb[2];
            auto ld = [&](int g, u32x4 (&r)[2]) { const size_t off = (size_t)(row0 + (g >> 2) * HALF + (g & 3) * 16) * ldc + col0;
#pragma unroll
                for (int q = 0; q < 2; ++q) r[q] = *(const u32x4*)(xin_b + off + q * HALF); };
            auto cv = [&](const u32x4 (&r)[2], f32x4 (&x)[4]) {
#pragma unroll
                for (int q = 0; q < 2; ++q) { x[2 * q] = (f32x4){bflo(r[q].x), bfhi(r[q].x), bflo(r[q].y), bfhi(r[q].y)}; x[2 * q + 1] = (f32x4){bflo(r[q].z), bfhi(r[q].z), bflo(r[q].w), bfhi(r[q].w)}; } };
            ld(0, ra);
#pragma unroll
            for (int g = 0; g < 8; g += 2) { f32x4 x[4];
                ld(g + 1, rb); __builtin_amdgcn_sched_barrier(0); cv(ra, x); finish(g, x); __builtin_amdgcn_sched_barrier(0);
                if (g + 2 < 8) ld(g + 2, ra); __builtin_amdgcn_sched_barrier(0); cv(rb, x); finish(g + 1, x); __builtin_amdgcn_sched_barrier(0); }
        }
        if (xb) {
            asm volatile("s_waitcnt lgkmcnt(0)" ::: "memory"); __builtin_amdgcn_s_barrier(); asm volatile("" ::: "memory");
            if (fq == 0) {
#pragma unroll
                for (int ai = 0; ai < 2; ++ai) { const f32x4 t = *(const LAS f32x4*)(tab + ((ai * 2 + wr) * 64 + wc * 16 + fr) * 4);
                    ssq[(size_t)(u.pm * BM + wr * 64 + fr + ai * HALF + wc * 16) * 16 + u.pn] = (t[0] + t[1]) + (t[2] + t[3]); } }
        }
    }
};

template <class Epi, class Sched, bool ALIGN_EPI = false, bool SP2 = false>
__device__ __forceinline__ void gemm_phase(LAS unsigned char* lds, const Gemm g, const Sched& S, const Epi& E, int tid) {
    const int wid = __builtin_amdgcn_readfirstlane(tid >> 6), lane = tid & 63, wr = wid >> 2, wc = wid & 3, fr = lane & 15, fq = lane >> 4;
    const int K = g.ld, nt = g.K / BK;
    unsigned voffA[2], voffB[2];
#pragma unroll
    for (int i = 0; i < 2; ++i) { int R, C; stage_rc(tid * 16 + i * 8192, R, C); const int Rb = Epi::PERM ? ((R & ~31) + perm32(R & 31)) : R;
        voffA[i] = (unsigned)(R * K + C) * 2u; voffB[i] = (unsigned)(Rb * K + C) * 2u; }
    const size_t kstep = (size_t)(BK * 2);
    const size_t hstep = (size_t)HALF * K * 2;
    const size_t tstep = 2 * hstep;
    const unsigned ldsw = (unsigned)wid * 1024u;
    const int aoff = lds_byte(wr * 64 + fr, fq * 8), boff = lds_byte(wc * 32 + fr, fq * 8);
#define PG8_SA(b, h) (((b) * 2 + (h)) * HTB)
#define PG8_SB(b, h) ((4 + (b) * 2 + (h)) * HTB)
#define PG8_STAGE(bufoff, gbase, voff) do { _Pragma("unroll") for (int _i = 0; _i < 2; ++_i) \
        __builtin_amdgcn_global_load_lds((const unsigned*)((const char*)(gbase) + (voff)[_i]), (LAS unsigned*)(lds + (bufoff) + ldsw + _i * 8192), 16, 0, 0); } while (0)
#define PG8_LDA(dst, b, h) do { _Pragma("unroll") for (int m = 0; m < 4; ++m) _Pragma("unroll") for (int k = 0; k < 2; ++k) dst[m][k] = *(const LAS bf16x8*)(lds + PG8_SA(b, h) + aoff + m * 2048 + k * 1024); } while (0)
#define PG8_LDB(dst, b, h) do { _Pragma("unroll") for (int n = 0; n < 2; ++n) _Pragma("unroll") for (int k = 0; k < 2; ++k) dst[n][k] = *(const LAS bf16x8*)(lds + PG8_SB(b, h) + boff + n * 2048 + k * 1024); } while (0)
#define PG8_MMA(ai, bj, At, Bt) do { __builtin_amdgcn_s_setprio(1); _Pragma("unroll") for (int m = 0; m < 4; ++m) _Pragma("unroll") for (int n = 0; n < 2; ++n) _Pragma("unroll") for (int k = 0; k < 2; ++k) \
        acc[ai][bj][m][n] = __builtin_amdgcn_mfma_f32_16x16x32_bf16(Bt[n][k], At[m][k], acc[ai][bj][m][n], 0, 0, 0); __builtin_amdgcn_s_setprio(0); } while (0)
#define PG8_WAIT_V(n) asm volatile("s_waitcnt vmcnt(" #n ")" ::: "memory")
#define PG8_WAIT_L(n) asm volatile("s_waitcnt lgkmcnt(" #n ")" ::: "memory")
#define PG8_BAR __builtin_amdgcn_s_barrier()
#define PG8_SCHED __builtin_amdgcn_sched_barrier(0)
    Unit cur, nxt; int ui = 0;
    if (!S.next(0, cur)) return;
    f32x4 acc[2][2][4][2];
#pragma unroll
    for (int a = 0; a < 2; ++a)
#pragma unroll
        for (int b = 0; b < 2; ++b)
#pragma unroll
            for (int m = 0; m < 4; ++m)
#pragma unroll
                for (int n = 0; n < 2; ++n) acc[a][b][m][n] = (f32x4){0.f, 0.f, 0.f, 0.f};
    bf16x8 At[4][2], B0[2][2], B1[2][2];
    const char* cA = (const char*)g.A + S.offA(cur, tstep); const char* cB = (const char*)g.Bt + S.offB(cur, tstep);
    S.a_ready(cur);
    if constexpr (SP2) {
        PG8_STAGE(PG8_SB(0, 0), cB, voffB); PG8_STAGE(PG8_SB(0, 1), cB + hstep, voffB); PG8_STAGE(PG8_SA(0, 0), cA, voffA); PG8_STAGE(PG8_SA(0, 1), cA + hstep, voffA);
        if (wr == 1) PG8_BAR;
        PG8_WAIT_V(2); PG8_BAR;
        PG8_STAGE(PG8_SB(1, 0), cB + kstep, voffB); PG8_STAGE(PG8_SA(1, 0), cA + kstep, voffA); PG8_STAGE(PG8_SB(1, 1), cB + hstep + kstep, voffB);
        PG8_WAIT_V(6); PG8_BAR;
    } else {
        PG8_STAGE(PG8_SB(0, 0), cB, voffB); PG8_STAGE(PG8_SA(0, 0), cA, voffA); PG8_STAGE(PG8_SB(0, 1), cB + hstep, voffB); PG8_STAGE(PG8_SA(0, 1), cA + hstep, voffA);
        if (wr == 1) PG8_BAR;
        PG8_WAIT_V(4); PG8_BAR;
        PG8_STAGE(PG8_SB(1, 0), cB + kstep, voffB); PG8_STAGE(PG8_SA(1, 0), cA + kstep, voffA); PG8_STAGE(PG8_SB(1, 1), cB + hstep + kstep, voffB);
        PG8_WAIT_V(6); PG8_BAR;
    }
    for (;;) {
        const bool has_next = S.next(ui + 1, nxt);
        const char* nA = has_next ? (const char*)g.A + S.offA(nxt, tstep) : cA; const char* nB = has_next ? (const char*)g.Bt + S.offB(nxt, tstep) : cB;
        for (int t = 0; t < nt; t += 2) {
            const bool last = (t == nt - 2);
            const char* a1 = cA + (size_t)(t + 1) * kstep;
            const char* a2 = last ? nA : cA + (size_t)(t + 2) * kstep; const char* b2 = last ? nB : cB + (size_t)(t + 2) * kstep;
            const char* a3 = a2 + kstep; const char* b3 = b2 + kstep;
            if (last && has_next) S.a_ready(nxt);
            if constexpr (SP2) {
            PG8_LDB(B0, 0, 0); PG8_LDB(B1, 0, 1); PG8_SCHED; PG8_LDA(At, 0, 0); PG8_STAGE(PG8_SA(1, 1), a1 + hstep, voffA);
            PG8_WAIT_V(8); PG8_WAIT_L(0); PG8_BAR; PG8_MMA(0, 0, At, B0); PG8_MMA(0, 1, At, B1); PG8_BAR; PG8_SCHED;
            PG8_LDA(At, 0, 1); PG8_STAGE(PG8_SB(0, 0), b2, voffB); PG8_STAGE(PG8_SB(0, 1), b2 + hstep, voffB); PG8_STAGE(PG8_SA(0, 0), a2, voffA);
            PG8_WAIT_V(8); PG8_WAIT_L(0); PG8_BAR; PG8_MMA(1, 0, At, B0); PG8_MMA(1, 1, At, B1); PG8_BAR; PG8_SCHED;
            PG8_LDB(B0, 1, 0); PG8_LDB(B1, 1, 1); PG8_SCHED; PG8_LDA(At, 1, 0); PG8_STAGE(PG8_SA(0, 1), a2 + hstep, voffA);
            PG8_WAIT_V(8); PG8_WAIT_L(0); PG8_BAR; PG8_MMA(0, 0, At, B0); PG8_MMA(0, 1, At, B1); PG8_BAR; PG8_SCHED;
            PG8_LDA(At, 1, 1); PG8_STAGE(PG8_SB(1, 0), b3, voffB); PG8_STAGE(PG8_SB(1, 1), b3 + hstep, voffB); PG8_STAGE(PG8_SA(1, 0), a3, voffA);
            PG8_WAIT_V(8); PG8_WAIT_L(0); PG8_BAR; PG8_MMA(1, 0, At, B0); PG8_MMA(1, 1, At, B1); PG8_BAR; PG8_SCHED;
            } else {
            PG8_LDB(B0, 0, 0); PG8_SCHED; PG8_LDA(At, 0, 0); PG8_STAGE(PG8_SA(1, 1), a1 + hstep, voffA);
            PG8_WAIT_L(8); PG8_BAR; PG8_WAIT_L(0); PG8_MMA(0, 0, At, B0); PG8_BAR; PG8_SCHED;
            PG8_LDB(B1, 0, 1); PG8_STAGE(PG8_SB(0, 0), b2, voffB);
            PG8_BAR; PG8_WAIT_L(0); PG8_MMA(0, 1, At, B1); PG8_BAR;
            PG8_LDA(At, 0, 1); PG8_STAGE(PG8_SA(0, 0), a2, voffA);
            PG8_BAR; PG8_WAIT_L(0); PG8_MMA(1, 0, At, B0); PG8_BAR; PG8_SCHED;
            PG8_STAGE(PG8_SB(0, 1), b2 + hstep, voffB);
            PG8_WAIT_V(6); PG8_BAR; PG8_MMA(1, 1, At, B1); PG8_BAR;
            PG8_LDB(B0, 1, 0); PG8_SCHED; PG8_LDA(At, 1, 0); PG8_STAGE(PG8_SA(0, 1), a2 + hstep, voffA);
            PG8_WAIT_L(8); PG8_BAR; PG8_WAIT_L(0); PG8_MMA(0, 0, At, B0); PG8_BAR; PG8_SCHED;
            PG8_LDB(B1, 1, 1); PG8_STAGE(PG8_SB(1, 0), b3, voffB);
            PG8_BAR; PG8_WAIT_L(0); PG8_MMA(0, 1, At, B1); PG8_BAR;
            PG8_LDA(At, 1, 1); PG8_STAGE(PG8_SA(1, 0), a3, voffA);
            PG8_BAR; PG8_WAIT_L(0); PG8_MMA(1, 0, At, B0); PG8_BAR; PG8_SCHED;
            PG8_STAGE(PG8_SB(1, 1), b3 + hstep, voffB);
            PG8_WAIT_V(6); PG8_BAR; PG8_MMA(1, 1, At, B1); PG8_BAR;
            }
        }
        if constexpr (ALIGN_EPI) { if (wr == 0) PG8_BAR; }
        if constexpr (!Epi::AFTER_DRAIN) { E(acc, cur, wr, wc, fr, fq); S.done(cur); }
        if (!has_next) break;
#pragma unroll
        for (int a = 0; a < 2; ++a)
#pragma unroll
            for (int b = 0; b < 2; ++b)
#pragma unroll
                for (int m = 0; m < 4; ++m)
#pragma unroll
                    for (int n = 0; n < 2; ++n) acc[a][b][m][n] = (f32x4){0.f, 0.f, 0.f, 0.f};
        cur = nxt; cA = nA; cB = nB; ++ui;
        if constexpr (ALIGN_EPI) { if (wr == 1) PG8_BAR; }
    }
    PG8_WAIT_V(0);
    if constexpr (!ALIGN_EPI) { if (wr == 0) PG8_BAR; }
    PG8_BAR;
#undef PG8_SA
#undef PG8_SB
#undef PG8_STAGE
#undef PG8_LDA
#undef PG8_LDB
#undef PG8_MMA
#undef PG8_WAIT_V
#undef PG8_WAIT_L
#undef PG8_BAR
#undef PG8_SCHED
}
}

namespace att {
constexpr int D = 128, NW = 8, QBLK = 32, KVBLK = 64, QB = NW * QBLK;
constexpr int SHM_V = KVBLK * D * 2, SHM_K = KVBLK * D * 2;
constexpr int OFF_WS = 2 * SHM_V + 2 * SHM_K;
constexpr int OFF_BIAS = OFF_WS + NW * 64 * 4;
constexpr int OFF_QW = OFF_BIAS + NW * 2 * 64 * 4;
constexpr int ATT_LDS = OFF_QW + 16;
constexpr float SCALE = 0.08838834764831845f;
constexpr float THR2 = 8.f * 1.4426950408889634f;
constexpr int W = S_;
constexpr int LD = LDP;

#define KSWZ(row, colB) ((row) * 256 + ((colB) ^ (((row) & 7) << 4)))
#define SBAR() __builtin_amdgcn_sched_barrier(0)
__device__ __forceinline__ int v_st(int k, int c) { const int kk = (k & ~0xC) | ((k & 4) << 1) | ((k & 8) >> 1); return ((kk >> 3) * 4 + (c >> 5)) * 512 + ((kk & 7) * 32 + (c & 31)) * 2; }
__device__ __forceinline__ int v_rd_base(int lane) { return ((lane & 3) << 3) | (((lane >> 2) & 3) << 6) | (((lane >> 4) & 1) << 5) | (((lane >> 5) & 1) << 8); }
constexpr int v_rd_off(int d0, int ks, int half) { return d0 * 512 + ks * 4096 + half * 2048; }
__device__ __forceinline__ int crow(int r, int hi) { return (r & 3) + 8 * (r >> 2) + 4 * hi; }
__device__ __forceinline__ unsigned cvtpk(float lo, float hi) { unsigned r; asm volatile("v_cvt_pk_bf16_f32 %0, %1, %2" : "=v"(r) : "v"(lo), "v"(hi)); return r; }
__device__ __forceinline__ bf16x8 load8(const bf16* p) { return *reinterpret_cast<const bf16x8*>(p); }
__device__ __forceinline__ int fresh_lane() { int l; asm volatile("v_mbcnt_lo_u32_b32 %0, -1, 0\n\tv_mbcnt_hi_u32_b32 %0, -1, %0" : "=v"(l)); return l; }

__device__ __forceinline__ void mask_tile(f32x16& p0, f32x16& p1, int dq, unsigned Wu) {
    const float NEG = -__builtin_inff();
#pragma unroll
    for (int r = 0; r < 16; ++r) {
        const int c = (r & 3) + 8 * (r >> 2);
        if ((unsigned)(dq - c) >= Wu) p0[r] = NEG;
        if ((unsigned)(dq - c - 32) >= Wu) p1[r] = NEG;
    }
}
#define PK4(P, B_, OUT) do { unsigned a0 = cvt_pk_bf16(P[B_+0], P[B_+1]), a1 = cvt_pk_bf16(P[B_+2], P[B_+3]);                          \
        unsigned b0 = cvt_pk_bf16(P[B_+4], P[B_+5]), b1 = cvt_pk_bf16(P[B_+6], P[B_+7]);                                             \
        auto r0 = __builtin_amdgcn_permlane32_swap(a0, b0, false, false); auto r1 = __builtin_amdgcn_permlane32_swap(a1, b1, false, false); \
        u32x4 w = {r0[0], r1[0], r0[1], r1[1]}; OUT = *reinterpret_cast<bf16x8*>(&w); } while (0)
__device__ __forceinline__ void expA(f32x16& p0, float& ps, bf16x8& pa0, bf16x8& pa1) {
#pragma unroll
    for (int r = 0; r < 16; ++r) p0[r] = __builtin_amdgcn_exp2f(p0[r]);
    float t = 0;
#pragma unroll
    for (int r = 0; r < 16; ++r) t += p0[r];
    ps = t;
    PK4(p0, 0, pa0); PK4(p0, 8, pa1);
}
__device__ __forceinline__ void finishSM(f32x16& p1, float ps0, float& l_reg, bf16x8& pa2, bf16x8& pa3) {
#pragma unroll
    for (int r = 0; r < 16; ++r) p1[r] = __builtin_amdgcn_exp2f(p1[r]);
    float ps = ps0;
#pragma unroll
    for (int r = 0; r < 16; ++r) ps += p1[r];
    l_reg += ps;
    PK4(p1, 0, pa2); PK4(p1, 8, pa3);
}
}

namespace att2 {
using att::crow; using att::mask_tile; using att::expA; using att::finishSM; using att::fresh_lane; using att::load8;
constexpr int LD = LDP, QB = 256, KVBLK = 64, W = S_;
template <int NV> struct Lay { static constexpr int K_OFF = 0, V_OFF = 32768, V_BUF = NV * 16384, LI_OFF = V_OFF + 2 * V_BUF, BIAS_OFF = LI_OFF + 8 * 32 * 4, QW_OFF = BIAS_OFF + 8 * 128 * 4, ORD_OFF = QW_OFF + 16, QL_OFF = ORD_OFF + 128, BYTES = QL_OFF + 8 * 6144; };
struct Blk { const bf16* Q; const bf16* K; const bf16* V; const float* bias; int P0; int oc; int plane; int jlo; };

template <int NV, int KS0>
__device__ __forceinline__ void pv_half(f32x16* o, int vbase, const int (&kv)[4], bf16x8 qa, bf16x8 qb) {
    constexpr int G = NV * 4, U = 2 * G;
#define PV_RD(u, F) do { if constexpr ((u) < U) { asm volatile("ds_read_b128 %0, %1 offset:%2" : "=&v"(F) : "v"(vbase + kv[KS0 + (u) / G]), "i"(((u) % G) * 4096) : "memory"); } } while (0)
#define PV_WM(u, F) do { if constexpr ((u) < U) { constexpr int left_ = U - 1 - (u); constexpr int n_ = left_ < 3 ? left_ : 3;                                  \
        asm volatile("s_waitcnt lgkmcnt(%1)" : "+v"(F) : "i"(n_) : "memory");                                                                               \
        o[(u) % G] = __builtin_amdgcn_mfma_f32_32x32x16_bf16(((u) / G) ? qb : qa, F, o[(u) % G], 0, 0, 0); } } while (0)
    bf16x8 f0, f1, f2, f3;
    PV_RD(0, f0); PV_RD(1, f1); PV_RD(2, f2);
#define PV_Q(u) PV_RD((u) + 3, f3); PV_WM((u), f0); PV_RD((u) + 4, f0); PV_WM((u) + 1, f1); PV_RD((u) + 5, f1); PV_WM((u) + 2, f2); PV_RD((u) + 6, f2); PV_WM((u) + 3, f3);
    PV_Q(0) PV_Q(4)
    if constexpr (NV == 2) { PV_Q(8) PV_Q(12) }
#undef PV_Q
#undef PV_WM
#undef PV_RD
}
template <int KB, bool FOX>
__device__ __forceinline__ void qkt(f32x16& p0, f32x16& p1, const char* lds, int r32, int hi, const bf16x8* qr, const float* bl) {
    if (FOX) {
#pragma unroll
        for (int g = 0; g < 4; ++g) { const f32x4 b = *(const f32x4*)(bl + KB * 64 + 8 * g); p0[4 * g] = b[0]; p0[4 * g + 1] = b[1]; p0[4 * g + 2] = b[2]; p0[4 * g + 3] = b[3]; }
#pragma unroll
        for (int g = 0; g < 4; ++g) { const f32x4 b = *(const f32x4*)(bl + KB * 64 + 32 + 8 * g); p1[4 * g] = b[0]; p1[4 * g + 1] = b[1]; p1[4 * g + 2] = b[2]; p1[4 * g + 3] = b[3]; }
    } else { p0 = f32x16{}; p1 = f32x16{}; }
    const char* kb[4];
#pragma unroll
    for (int dd = 0; dd < 4; ++dd) kb[dd] = lds + KB * 16384 + KSWZ(r32, (dd * 16 + hi * 8) * 2);
#pragma unroll
    for (int d0 = 0; d0 < 8; ++d0) { const char* a = kb[d0 & 3] + (d0 >> 2) * 128;
        bf16x8 b0 = *reinterpret_cast<const bf16x8*>(a);
        bf16x8 b1 = *reinterpret_cast<const bf16x8*>(a + 32 * 256);
        p0 = __builtin_amdgcn_mfma_f32_32x32x16_bf16(b0, qr[d0], p0, 0, 0, 0);
        p1 = __builtin_amdgcn_mfma_f32_32x32x16_bf16(b1, qr[d0], p1, 0, 0, 0); }
}
#define MFMA16(a_, b_, c_) __builtin_amdgcn_mfma_f32_16x16x32_bf16(a_, b_, c_, 0, 0, 0)
template <int KB, bool FOX, int H>
__device__ __forceinline__ void qkt16(f32x4 (&p)[2][2], int ka0, const bf16x8 (&qr)[2][4], const float* bl) {
#pragma unroll
    for (int kbl = 0; kbl < 2; ++kbl) {
        f32x4 b0 = {0.f, 0.f, 0.f, 0.f};
        if (FOX) b0 = *(const f32x4*)(bl + KB * 64 + 32 * H + 16 * kbl);
        p[kbl][0] = b0; p[kbl][1] = b0; }
#define KQ_RD(n_, F) do { if constexpr ((n_) < 8) asm volatile("ds_read_b128 %0, %1 offset:%2" : "=&v"(F) : "v"(ka0 ^ (((n_) >> 1) * 64)), "i"(KB * 16384 + (2 * H + ((n_) & 1)) * 4096) : "memory"); } while (0)
#define KQ_MM(n_, F) do { constexpr int w_ = (7 - (n_)) < 3 ? (7 - (n_)) : 3;                                                                                  \
        asm volatile("s_waitcnt lgkmcnt(%1)" : "+v"(F) : "i"(w_) : "memory");                                                                                  \
        p[(n_) & 1][0] = MFMA16(F, qr[0][(n_) >> 1], p[(n_) & 1][0]); p[(n_) & 1][1] = MFMA16(F, qr[1][(n_) >> 1], p[(n_) & 1][1]); } while (0)
    bf16x8 f0, f1, f2, f3;
    KQ_RD(0, f0); KQ_RD(1, f1); KQ_RD(2, f2);
    KQ_RD(3, f3); KQ_MM(0, f0); KQ_RD(4, f0); KQ_MM(1, f1); KQ_RD(5, f1); KQ_MM(2, f2); KQ_RD(6, f2); KQ_MM(3, f3);
    KQ_RD(7, f3); KQ_MM(4, f0); KQ_MM(5, f1); KQ_MM(6, f2); KQ_MM(7, f3);
#undef KQ_RD
#undef KQ_MM
}
template <int KB>
__device__ __forceinline__ void kq_pref(int ka0, bf16x8& f0, bf16x8& f1, bf16x8& f2) {
    asm volatile("ds_read_b128 %0, %3 offset:%4\n\tds_read_b128 %1, %3 offset:%5\n\tds_read_b128 %2, %3 offset:%6" : "=&v"(f0), "=&v"(f1), "=&v"(f2) : "v"(ka0), "i"(KB * 16384), "i"(KB * 16384 + 4096), "i"(KB * 16384 + 8192) : "memory");
}
template <int KB, bool FOX>
__device__ __forceinline__ void qkt16f(f32x4 (&p0)[2][2], f32x4 (&p1)[2][2], int ka0, const bf16x8 (&qr)[2][4], const float* bl, bf16x8& f0, bf16x8& f1, bf16x8& f2) {
#pragma unroll
    for (int kbl = 0; kbl < 2; ++kbl) {
        f32x4 b0 = {0.f, 0.f, 0.f, 0.f}, b1 = {0.f, 0.f, 0.f, 0.f};
        if (FOX) { b0 = *(const f32x4*)(bl + KB * 64 + 16 * kbl); b1 = *(const f32x4*)(bl + KB * 64 + 32 + 16 * kbl); }
        p0[kbl][0] = b0; p0[kbl][1] = b0; p1[kbl][0] = b1; p1[kbl][1] = b1; }
#define KQ_RD(n_, F) do { if constexpr ((n_) < 16) asm volatile("ds_read_b128 %0, %1 offset:%2" : "=&v"(F) : "v"(ka0 ^ (((n_) >> 2) * 64)), "i"(KB * 16384 + ((n_) & 3) * 4096) : "memory"); } while (0)
#define KQ_MM(n_, F, P_, kl_) do { constexpr int w_ = (15 - (n_)) < 3 ? (15 - (n_)) : 3;                                                                         \
        asm volatile("s_waitcnt lgkmcnt(%1)" : "+v"(F) : "i"(w_) : "memory");                                                                                  \
        P_[kl_][0] = MFMA16(F, qr[0][(n_) >> 2], P_[kl_][0]); P_[kl_][1] = MFMA16(F, qr[1][(n_) >> 2], P_[kl_][1]); } while (0)
    bf16x8 f3;
#define KQ_Q(n_) KQ_RD((n_) + 3, f3); KQ_MM((n_), f0, p0, 0); KQ_RD((n_) + 4, f0); KQ_MM((n_) + 1, f1, p0, 1); KQ_RD((n_) + 5, f1); KQ_MM((n_) + 2, f2, p1, 0); KQ_RD((n_) + 6, f2); KQ_MM((n_) + 3, f3, p1, 1);
    KQ_Q(0) KQ_Q(4) KQ_Q(8) KQ_Q(12)
#undef KQ_Q
#undef KQ_RD
#undef KQ_MM
}
template <int H>
__device__ __forceinline__ void mask16(f32x4 (&p)[2][2], int dq) {
    const float NEG = -__builtin_inff();
#pragma unroll
    for (int kbl = 0; kbl < 2; ++kbl)
#pragma unroll
        for (int rbk = 0; rbk < 2; ++rbk)
#pragma unroll
            for (int r = 0; r < 4; ++r) { if (dq + 16 * rbk - 32 * H - 16 * kbl - r < 0) p[kbl][rbk][r] = NEG; }
}
__device__ __forceinline__ bf16x8 pack16(const f32x4& a, const f32x4& b) { u32x4 w = {cvt_pk_bf16(a[0], a[1]), cvt_pk_bf16(a[2], a[3]), cvt_pk_bf16(b[0], b[1]), cvt_pk_bf16(b[2], b[3])}; return *reinterpret_cast<bf16x8*>(&w); }
__device__ __forceinline__ void exp16(f32x4 (&p)[2][2], float (&ps)[2], bf16x8 (&pa)[2]) {
#pragma unroll
    for (int kbl = 0; kbl < 2; ++kbl)
#pragma unroll
        for (int rbk = 0; rbk < 2; ++rbk)
#pragma unroll
            for (int r = 0; r < 4; ++r) p[kbl][rbk][r] = __builtin_amdgcn_exp2f(p[kbl][rbk][r]);
#pragma unroll
    for (int rbk = 0; rbk < 2; ++rbk) { ps[rbk] += ((p[0][rbk][0] + p[0][rbk][1]) + (p[0][rbk][2] + p[0][rbk][3])) + ((p[1][rbk][0] + p[1][rbk][1]) + (p[1][rbk][2] + p[1][rbk][3]));
        pa[rbk] = pack16(p[0][rbk], p[1][rbk]); }
    asm volatile("" : "+v"(ps[0]), "+v"(ps[1]));
}
__device__ __forceinline__ void pv_pref(int vaddr, bf16x8& f0, bf16x8& f1, bf16x8& f2) {
    asm volatile("ds_read_b128 %0, %3\n\tds_read_b128 %1, %3 offset:2048\n\tds_read_b128 %2, %3 offset:4096" : "=&v"(f0), "=&v"(f1), "=&v"(f2) : "v"(vaddr) : "memory");
}
template <int NV>
__device__ __forceinline__ void pv16(f32x4 (&o)[2][NV * 8], int vaddr, const bf16x8 (&pa)[2], const bf16x8 (&pb)[2], bf16x8& f0, bf16x8& f1, bf16x8& f2) {
    constexpr int G = NV * 8, U = 2 * G;
#define PV_RD(u, F) do { if constexpr ((u) < U) { asm volatile("ds_read_b128 %0, %1 offset:%2" : "=&v"(F) : "v"(((u) / G) ? (vaddr ^ 64) : vaddr), "i"(((u) % G) * 2048) : "memory"); } } while (0)
#define PV_WM(u, F) do { if constexpr ((u) < U) { constexpr int left_ = U - 1 - (u); constexpr int n_ = left_ < 3 ? left_ : 3; constexpr int c_ = (u) % G;       \
        asm volatile("s_waitcnt lgkmcnt(%1)" : "+v"(F) : "i"(n_) : "memory");                                                                               \
        o[0][c_] = MFMA16(F, ((u) / G) ? pb[0] : pa[0], o[0][c_]); o[1][c_] = MFMA16(F, ((u) / G) ? pb[1] : pa[1], o[1][c_]); } } while (0)
    bf16x8 f3;
#define PV_Q(u) PV_RD((u) + 3, f3); PV_WM((u), f0); PV_RD((u) + 4, f0); PV_WM((u) + 1, f1); PV_RD((u) + 5, f1); PV_WM((u) + 2, f2); PV_RD((u) + 6, f2); PV_WM((u) + 3, f3);
    PV_Q(0) PV_Q(4) PV_Q(8) PV_Q(12)
    if constexpr (NV == 2) { PV_Q(16) PV_Q(20) PV_Q(24) PV_Q(28) }
#undef PV_Q
#undef PV_WM
#undef PV_RD
}
#define GLDS16(gp, lp) __builtin_amdgcn_global_load_lds((const unsigned*)(gp), (LAS unsigned*)(lp), 16, 0, 0)
#define A2_DMA(B_, k0, KB) do { const bf16* kg_ = (B_).K + (size_t)(k0) * LD; const bf16* vg_ = (B_).V + (k0);     \
        const u32x4 ot_ = ((volatile u32x4*)(lds + Lay<NV>::QL_OFF))[wid * 64 + fresh_lane()]; unsigned o0_ = ot_.x, o1_ = ot_.y, va_ = ot_.z, vb_ = ot_.w;     \
        GLDS16(kg_ + o0_, ldsl + (KB) * 16384 + wid * 2048); GLDS16(kg_ + o1_, ldsl + (KB) * 16384 + wid * 2048 + 1024);                          \
        GLDS16(vg_ + va_, ldsl + Lay<NV>::V_OFF + (KB) * Lay<NV>::V_BUF + wid * (NV * 2048)); GLDS16(vg_ + vb_, ldsl + Lay<NV>::V_OFF + (KB) * Lay<NV>::V_BUF + wid * (NV * 2048) + 1024);   \
        if constexpr (NV == 2) { GLDS16(vg_ + (size_t)16 * S_ + va_, ldsl + Lay<NV>::V_OFF + (KB) * Lay<NV>::V_BUF + wid * 4096 + 2048);          \
                                 GLDS16(vg_ + (size_t)16 * S_ + vb_, ldsl + Lay<NV>::V_OFF + (KB) * Lay<NV>::V_BUF + wid * 4096 + 3072); } } while (0)

template <int NV, bool FOX>
__device__ __forceinline__ void attn2_phase(const bf16* Pb, const bf16* VT, const float* dk, const int* jlo_tab, unsigned* qctr, bf16* abuf, float* opart, char* lds, LAS unsigned char* ldsl, int vcu, int G, int tid,
                                            float lam = 0.f, float post = 0.f, const float* sg = nullptr) {
    const int wid = __builtin_amdgcn_readfirstlane(tid >> 6), lane = tid & 63, r32 = lane & 31, hi = lane >> 5;
    volatile unsigned* qw = (volatile unsigned*)(lds + Lay<NV>::QW_OFF); volatile unsigned* ordt = (volatile unsigned*)(lds + Lay<NV>::ORD_OFF);
    constexpr int total = FOX ? 24 * 64 : 24 * 32;
    auto mk = [&](int L, int pass) -> Blk {
        Blk b;
        if (FOX) { const int it = L < total ? L : total - 1; const int qb = 63 - (it & 63), h = __builtin_amdgcn_readfirstlane((int)ordt[it >> 6]);
            b.P0 = qb * 256; b.jlo = jlo_tab[h * 64 + qb] & ~1;
            b.Q = Pb + (size_t)b.P0 * LD + QC + h * 128; b.K = Pb + KC + h * 128; b.V = VT + (size_t)(h * 128) * S_; b.bias = dk + (size_t)h * S_; b.oc = h * 128; b.plane = 0; }
        else { const int it3 = L >> 8, x8 = (L >> 5) & 7, xx = L & 31; const int qb = pass ? 63 - xx : xx;
               const int h = it3 < 2 ? x8 : (x8 < 4 ? 8 + x8 : 4 + x8), c = it3 < 2 ? it3 : (x8 < 4 ? 0 : 1);
            b.P0 = qb * 256; b.jlo = 0;
            b.Q = Pb + (size_t)b.P0 * LD + QC + c * 1536 + h * 128; b.K = Pb + KC + c * 1536 + h * 128; b.V = VT + (size_t)(h * 256) * S_; b.bias = nullptr; b.oc = h * 256; b.plane = c; }
        return b; };
    const int j16 = lane & 15, q4 = lane >> 4; (void)r32; (void)hi;
    float* B_w = (float*)(lds + Lay<NV>::BIAS_OFF) + wid * 128; const float* bl = B_w + 4 * q4;
    constexpr float RC2 = 1.f;
    float bst = 0.f;
    int L = vcu, Lnx = 0;
    if (FOX) {
        if (tid < 24) {
            const int mine = 256 - jlo_tab[tid * 64 + 63]; int rank = 0;
            for (int h2 = 0; h2 < 24; ++h2) { const int o2 = 256 - jlo_tab[h2 * 64 + 63]; rank += (o2 > mine || (o2 == mine && h2 < tid)) ? 1 : 0; }
            ordt[rank] = (unsigned)tid;
        }
        if (tid == 0) { qw[0] = __hip_atomic_fetch_add(qctr, 1u, __ATOMIC_RELAXED, __HIP_MEMORY_SCOPE_AGENT); qw[1] = __hip_atomic_fetch_add(qctr, 1u, __ATOMIC_RELAXED, __HIP_MEMORY_SCOPE_AGENT); }
        __syncthreads();
        L = __builtin_amdgcn_readfirstlane((int)qw[0]); Lnx = __builtin_amdgcn_readfirstlane((int)qw[1]);
        __syncthreads();
    }
    if (L >= total) return;
    const int lr = lane >> 4, lc = lane & 15, kr = (lane & 31) >> 2;
    const unsigned offK0 = (unsigned)((8 * wid + lr) * LD + ((lc ^ (8 * (wid & 1) + lr)) * 8)), offK1 = (unsigned)((8 * wid + 4 + lr) * LD + ((lc ^ (8 * (wid & 1) + 4 + lr)) * 8));
    const int vr8 = lane >> 3, vm = vr8 >> 1;
    const unsigned offVa = (unsigned)((wid * NV * 16 + vr8) * S_ + (((lane & 7) ^ vm) * 8)), offVb = (unsigned)((wid * NV * 16 + 8 + vr8) * S_ + (((lane & 7) ^ (4 + vm)) * 8));
    const int vb0 = (int)(uintptr_t)lds;
    { u32x4 t_ = {offK0, offK1, offVa, offVb}; ((u32x4*)(lds + Lay<NV>::QL_OFF))[wid * 64 + lane] = t_; }
    const int ka0 = vb0 + j16 * 256 + ((q4 ^ j16) * 16), va0 = vb0 + j16 * 128 + ((q4 ^ ((j16 >> 1) & 7)) * 16);
    int pass = 0; Blk cur = mk(L, 0);
    A2_DMA(cur, cur.jlo * KVBLK, 0);
    if (FOX) { const float d0_ = cur.bias[cur.P0 + wid * 32]; bst = cur.bias[cur.jlo * KVBLK + lane]; B_w[lane] = (bst - d0_) * RC2; }
    for (;;) {
        bool last; int passn = 0, Ln = L;
        if (FOX) { last = Lnx >= total;
            if (tid == 0) qw[0] = last ? (unsigned)total : __hip_atomic_fetch_add(qctr, 1u, __ATOMIC_RELAXED, __HIP_MEMORY_SCOPE_AGENT);
            Ln = Lnx; }
        else { const bool more_pass = pass == 0, more_item = L + G < total; last = !more_pass && !more_item;
            passn = pass + 1; if (!more_pass) { passn = 0; Ln = more_item ? L + G : L; } }
        const Blk nxt = last ? cur : mk(Ln, passn);
        const int NT = cur.P0 / KVBLK + 4 - cur.jlo;
        const bool desc = !FOX && pass != 0; const int NTn = nxt.P0 / KVBLK + 4 - nxt.jlo; const bool descn = !FOX && passn != 0;
#define TIX(i) (cur.jlo + (desc ? NT - 1 - (i) : (i)))
        const int qlo = cur.P0 + wid * 32, qm = qlo + j16 - 4 * q4;
        float dref = 0.f, dref_n = 0.f;
        if (FOX) { dref = cur.bias[qlo]; dref_n = nxt.bias[nxt.P0 + wid * 32]; }
        bf16x8 qr[2][4];
        { const int lq = fresh_lane(); const unsigned qoff = (unsigned)((wid * 32 + (lq & 15)) * LD + (lq >> 4) * 8);
#pragma unroll
          for (int rbk = 0; rbk < 2; ++rbk)
#pragma unroll
              for (int ks = 0; ks < 4; ++ks) qr[rbk][ks] = load8(cur.Q + qoff + rbk * 16 * LD + ks * 32); }
        float l2[2] = {0.f, 0.f}; f32x4 o[2][NV * 8];
#pragma unroll
        for (int rbk = 0; rbk < 2; ++rbk)
#pragma unroll
            for (int i = 0; i < NV * 8; ++i) o[rbk][i] = f32x4{0.f, 0.f, 0.f, 0.f};
        asm volatile("s_waitcnt vmcnt(0)" ::: "memory"); __syncthreads();
#define A2_STEP(t, KB, NEXT_DMA, BIAS_WR) do { bf16x8 pa[2], pb[2], kf0, kf1, kf2, vf0, vf1, vf2;                                         \
            int k0_ = ka0, v0_ = va0; asm volatile("" : "+v"(k0_), "+v"(v0_)); v0_ += Lay<NV>::V_OFF + KB * Lay<NV>::V_BUF;                 \
            kq_pref<KB>(k0_, kf0, kf1, kf2);                                                                                           \
            NEXT_DMA;                                                                                                                  \
            { const int kb_ = TIX(t) * KVBLK; const bool dg_ = kb_ + KVBLK - 1 > qlo; f32x4 p0[2][2], p1[2][2];                         \
              qkt16f<KB, FOX>(p0, p1, k0_, qr, bl, kf0, kf1, kf2);                                                                      \
              pv_pref(v0_, vf0, vf1, vf2);                                                                                             \
              if (dg_) { mask16<0>(p0, qm - kb_); mask16<1>(p1, qm - kb_); }                                                            \
              exp16(p0, l2, pa); exp16(p1, l2, pb); }                                                                                  \
            __builtin_amdgcn_sched_barrier(0);                                                                                         \
            pv16<NV>(o, v0_, pa, pb, vf0, vf1, vf2);                                                                                   \
            asm volatile("s_waitcnt vmcnt(0)" ::: "memory"); BIAS_WR; __syncthreads(); } while (0)
        for (int t = 0; t < NT; t += 2) {
            A2_STEP(t, 0, do { A2_DMA(cur, TIX(t + 1) * KVBLK, 1); if (FOX) bst = cur.bias[TIX(t + 1) * KVBLK + lane]; } while (0),
                          do { if (FOX) B_w[64 + lane] = (bst - dref) * RC2; } while (0));
            A2_STEP(t + 1, 1, do { if (t + 2 < NT) { A2_DMA(cur, TIX(t + 2) * KVBLK, 0); if (FOX) bst = cur.bias[TIX(t + 2) * KVBLK + lane]; }
                                   else if (!last) { const int k0n_ = (nxt.jlo + (descn ? NTn - 1 : 0)) * KVBLK; A2_DMA(nxt, k0n_, 0); if (FOX) bst = nxt.bias[k0n_ + lane]; } } while (0),
                              do { if (FOX) B_w[lane] = (bst - ((t + 2 < NT) ? dref : dref_n)) * RC2; } while (0));
        }
#undef A2_STEP
#undef TIX
        const int le = fresh_lane(), je = le & 15, q4e = le >> 4;
        float rli[2];
#pragma unroll
        for (int rbk = 0; rbk < 2; ++rbk) { float l = l2[rbk]; l += shx(l, 16, le); l = half_sum(l); rli[rbk] = __builtin_amdgcn_rcpf(l); }
        if (FOX) {
#pragma unroll
            for (int rbk = 0; rbk < 2; ++rbk) { const int row = qlo + 16 * rbk + je;
                const bf16* gp = Pb + (size_t)row * LD + GC + cur.oc + 4 * q4e; bf16* op = abuf + (size_t)row * DM + cur.oc + 4 * q4e;
#pragma unroll
                for (int cb = 0; cb < NV * 8; ++cb) { const u32x2 g = *(const u32x2*)(gp + 16 * cb); const f32x4 v = o[rbk][cb] * rli[rbk];
                    u32x2 w; w.x = cvt_pk_bf16(v[0] * silu_f(bflo(g.x)), v[1] * silu_f(bfhi(g.x))); w.y = cvt_pk_bf16(v[2] * silu_f(bflo(g.y)), v[3] * silu_f(bfhi(g.y)));
                    *(u32x2*)(op + 16 * cb) = w; } }
        } else if (cur.oc < 8 * 256 && cur.plane == 1) {
#pragma unroll
          for (int rbk = 0; rbk < 2; ++rbk) { const int row = qlo + 16 * rbk + je;
              const bf16* pp = (const bf16*)opart + (size_t)row * MIXW + cur.oc + 4 * q4e; const bf16* gp = Pb + (size_t)row * LD + GC + cur.oc + 4 * q4e; bf16* op = abuf + (size_t)row * DM + cur.oc + 4 * q4e;
              float ss = 0.f;
#pragma unroll
              for (int cb = 0; cb < NV * 8; ++cb) { const unsigned long long a64 = __builtin_nontemporal_load((const unsigned long long*)(pp + 16 * cb)); const unsigned ax = (unsigned)a64, ay = (unsigned)(a64 >> 32);
                  const f32x4 o0 = {bflo(ax), bfhi(ax), bflo(ay), bfhi(ay)}; const f32x4 d = o0 - lam * (o[rbk][cb] * rli[rbk]); o[rbk][cb] = d;
                  ss += (d[0] * d[0] + d[1] * d[1]) + (d[2] * d[2] + d[3] * d[3]); }
              ss += shx(ss, 16, le); ss = half_sum(ss);
              const float rr = __builtin_amdgcn_rsqf(ss * (1.f / 256.f) + NORM_EPS) * post;
#pragma unroll
              for (int cb = 0; cb < NV * 8; ++cb) { const u32x2 g = *(const u32x2*)(gp + 16 * cb); const f32x4 sg4 = *(const f32x4*)(sg + 16 * cb + 4 * q4e); const f32x4 d = o[rbk][cb];
                  u32x2 w; w.x = cvt_pk_bf16(d[0] * rr * sg4[0] * silu_f(bflo(g.x)), d[1] * rr * sg4[1] * silu_f(bfhi(g.x))); w.y = cvt_pk_bf16(d[2] * rr * sg4[2] * silu_f(bflo(g.y)), d[3] * rr * sg4[3] * silu_f(bfhi(g.y)));
                  *(u32x2*)(op + 16 * cb) = w; } }
        } else {
#pragma unroll
          for (int rbk = 0; rbk < 2; ++rbk) { const int row = qlo + 16 * rbk + je;
              bf16* op = (bf16*)opart + (size_t)cur.plane * S_ * MIXW + (size_t)row * MIXW + cur.oc + 4 * q4e;
#pragma unroll
              for (int cb = 0; cb < NV * 8; ++cb) { const f32x4 v = o[rbk][cb] * rli[rbk]; u32x2 w; w.x = cvt_pk_bf16(v[0], v[1]); w.y = cvt_pk_bf16(v[2], v[3]); *(u32x2*)(op + 16 * cb) = w; } } }
        if (last) break;
        if (FOX) { const int inn = __builtin_amdgcn_readfirstlane((int)qw[0]); cur = nxt; L = Lnx; Lnx = inn; __syncthreads(); }
        else { cur = nxt; pass = passn; L = Ln; }
    }
    __syncthreads();
}

#undef GLDS16
#undef A2_DMA
}

#define XB_TMO      128
#define XB_XCNT(j)  (256  + 64 * (j))
#define XB_XSUB(j)  (1280 + 64 * (j))
#define XB_XGEN(j)  (2304 + 64 * (j))
#define XB_TOP      3328
#define XB_TOPGEN   3392
#define XCD_BAR_WORDS 3456
#define XB_SPIN_CAP (1u << 18)
__device__ __forceinline__ unsigned xb_ld(unsigned* p)              { return __hip_atomic_load(p, __ATOMIC_RELAXED, __HIP_MEMORY_SCOPE_AGENT); }
__device__ __forceinline__ unsigned xb_add(unsigned* p, unsigned v) { return __hip_atomic_fetch_add(p, v, __ATOMIC_RELAXED, __HIP_MEMORY_SCOPE_AGENT); }
__device__ __forceinline__ unsigned xb_xcc_id() { return (unsigned)__builtin_amdgcn_s_getreg((3 << 11) | 20) & 0xFu; }
#define XB_SPIN(cond, bar) do { unsigned _sp = 0; while (cond) { __builtin_amdgcn_s_sleep(1); \
    if ((++_sp & 255u) == 0u) { if (xb_ld(&(bar)[XB_TMO])) break; if (_sp > XB_SPIN_CAP) { atomicAdd(&(bar)[XB_TMO], 1u); break; } } } } while (0)
struct XcdBarrier { unsigned* bar; unsigned x; volatile LAS unsigned* st; };
__device__ __forceinline__ XcdBarrier xcd_barrier_post(unsigned* bar, volatile LAS unsigned* st) {
    XcdBarrier b; b.bar = bar; b.x = xb_xcc_id(); b.st = st;
    if (threadIdx.x == 0) (void)xb_add(&bar[XB_XCNT(b.x)], 1u);
    return b;
}
__device__ __forceinline__ void xcd_barrier_complete(unsigned* bar, unsigned x, unsigned& nloc, unsigned& nx) {
    const unsigned G = gridDim.x * gridDim.y * gridDim.z;
    unsigned sum, cnt, mine, sp = 0u;
    for (;;) {
        sum = 0u; cnt = 0u; mine = 0u;
#pragma unroll
        for (unsigned j = 0; j < 16; ++j) { const unsigned c = xb_ld(&bar[XB_XCNT(j)]); sum += c; cnt += (c > 0u) ? 1u : 0u; mine = (j == x) ? c : mine; }
        if (sum == G) break;
        __builtin_amdgcn_s_sleep(1);
        if ((++sp & 255u) == 0u) { if (xb_ld(&bar[XB_TMO])) break; if (sp > XB_SPIN_CAP) { atomicAdd(&bar[XB_TMO], 1u); break; } }
    }
    nloc = mine > 0u ? mine : 1u; nx = cnt > 0u ? cnt : 1u;
}
__device__ __forceinline__ void xcd_barrier(const XcdBarrier& b, bool thread0) {
    asm volatile("s_waitcnt vmcnt(0)" ::: "memory");
    __syncthreads();
    if (thread0) {
        unsigned* bar = b.bar;
        __builtin_amdgcn_s_waitcnt(0);
        unsigned nloc = b.st[0], nx = b.st[1];
        if (nloc == 0u) { xcd_barrier_complete(bar, b.x, nloc, nx); b.st[0] = nloc; b.st[1] = nx; }
        const unsigned old = xb_add(&bar[XB_XSUB(b.x)], 1u);
        const unsigned gen = old / nloc;
        if (old + 1u == (gen + 1u) * nloc) {
            __builtin_amdgcn_fence(__ATOMIC_RELEASE, "agent");
            asm volatile("s_waitcnt vmcnt(0)" ::: "memory");
            const unsigned og = xb_add(&bar[XB_TOP], 1u);
            const unsigned tg = og / nx;
            if (og + 1u == (tg + 1u) * nx) xb_add(&bar[XB_TOPGEN], 1u);
            else XB_SPIN(xb_ld(&bar[XB_TOPGEN]) == tg, bar);
            xb_add(&bar[XB_XGEN(b.x)], 1u);
            __builtin_amdgcn_fence(__ATOMIC_ACQUIRE, "agent");
            asm volatile("s_waitcnt vmcnt(0)" ::: "memory");
        } else {
            if (old == gen * nloc || old == gen * nloc + (nloc >> 1)) {
                __builtin_amdgcn_fence(__ATOMIC_RELEASE, "agent");
                asm volatile("s_waitcnt vmcnt(0)" ::: "memory");
            }
            XB_SPIN(xb_ld(&bar[XB_XGEN(b.x)]) == gen, bar);
            __builtin_amdgcn_fence(__ATOMIC_ACQUIRE, "agent");
            asm volatile("s_waitcnt vmcnt(0)" ::: "memory");
        }
    }
    __syncthreads();
}

__device__ __forceinline__ void tr_item(const float* W, int Nsrc, int c0, int nvalid, bf16* WT, int r0, LAS float* scr, int item, int nblk, int lane, const float* kgain = nullptr) {
    const int kb = item / nblk, nb = item - kb * nblk, k0 = 64 * kb, n0 = 32 * nb;
    const int nq = (lane & 7) * 4, kr = lane >> 3;
    const float* src = W + (size_t)(k0 + kr) * Nsrc + c0 + n0 + nq;
    f32x4 v[8];
    if (n0 + 32 <= nvalid) {
#pragma unroll
        for (int i = 0; i < 8; ++i) v[i] = *(const f32x4*)(src + (size_t)(8 * i) * Nsrc);
    } else {
#pragma unroll
        for (int i = 0; i < 8; ++i) { f32x4 t = {0.f, 0.f, 0.f, 0.f};
            if (n0 + nq + 0 < nvalid) t.x = src[(size_t)(8 * i) * Nsrc + 0]; if (n0 + nq + 1 < nvalid) t.y = src[(size_t)(8 * i) * Nsrc + 1];
            if (n0 + nq + 2 < nvalid) t.z = src[(size_t)(8 * i) * Nsrc + 2]; if (n0 + nq + 3 < nvalid) t.w = src[(size_t)(8 * i) * Nsrc + 3]; v[i] = t; }
    }
    if (kgain) {
#pragma unroll
        for (int i = 0; i < 8; ++i) v[i] = v[i] * kgain[k0 + 8 * i + kr];
    }
#pragma unroll
    for (int i = 0; i < 8; ++i) { LAS float* d = scr + (8 * i + kr) * 33 + nq; d[0] = v[i].x; d[1] = v[i].y; d[2] = v[i].z; d[3] = v[i].w; }
    LDS_WAIT(); asm volatile("" ::: "memory");
    const int c = lane & 7;
#pragma unroll
    for (int j = 0; j < 4; ++j) { const int n = (lane >> 3) + 8 * j; const LAS float* s = scr + (8 * c) * 33 + n;
        u32x4 o; o.x = cvt_pk_bf16(s[0 * 33], s[1 * 33]); o.y = cvt_pk_bf16(s[2 * 33], s[3 * 33]); o.z = cvt_pk_bf16(s[4 * 33], s[5 * 33]); o.w = cvt_pk_bf16(s[6 * 33], s[7 * 33]);
        *(u32x4*)(WT + (size_t)(r0 + n0 + n) * DM + k0 + 8 * c) = o; }
    LDS_WAIT(); asm volatile("" ::: "memory");
}
__device__ __forceinline__ void rms_row_to_bf16(const float* xrow, const float* g, bf16* orow, int lane) {
    const f32x4* xr = (const f32x4*)xrow + lane;
    f32x4 v[16]; float s = 0.f;
#pragma unroll
    for (int j = 0; j < 16; ++j) { v[j] = xr[64 * j]; s += (v[j].x * v[j].x + v[j].y * v[j].y) + (v[j].z * v[j].z + v[j].w * v[j].w); }
    const float rstd = __builtin_amdgcn_rsqf(wave_sum(s, lane) * (1.f / DM) + NORM_EPS);
    const f32x4* gr = (const f32x4*)g + lane;
    u32x2* o8 = (u32x2*)orow + lane;
#pragma unroll
    for (int j = 0; j < 16; ++j) { const f32x4 gg = gr[64 * j]; u32x2 w; w.x = cvt_pk_bf16(v[j].x * rstd * gg.x, v[j].y * rstd * gg.y); w.y = cvt_pk_bf16(v[j].z * rstd * gg.z, v[j].w * rstd * gg.w); o8[64 * j] = w; }
}

__device__ __forceinline__ void row_to_bf16_ssq(const float* xrow, bf16* orow, float* ssq, int lane) {
    const f32x4* xr = (const f32x4*)xrow + 2 * lane; u32x4* o16 = (u32x4*)orow + lane; float s = 0.f;
#pragma unroll
    for (int j = 0; j < 8; ++j) { const f32x4 v = xr[128 * j], u = xr[128 * j + 1];
        s += ((v.x * v.x + v.y * v.y) + (v.z * v.z + v.w * v.w)) + ((u.x * u.x + u.y * u.y) + (u.z * u.z + u.w * u.w));
        u32x4 w; w.x = cvt_pk_bf16(v.x, v.y); w.y = cvt_pk_bf16(v.z, v.w); w.z = cvt_pk_bf16(u.x, u.y); w.w = cvt_pk_bf16(u.z, u.w); o16[64 * j] = w; }
    s = wave_sum(s, lane);
    if (lane < 16) ssq[lane] = lane == 0 ? s : 0.f;
}

struct Args { const float* in[20]; float* out; unsigned char* ws; int ph_lo, ph_hi; };
typedef const __attribute__((address_space(4))) Args* ArgsP;
constexpr int N_PHASES = 3 + 6 * DEPTH;
constexpr int KV_SPLIT = 8;

#define MA_GLDS16(gp, lp) __builtin_amdgcn_global_load_lds((const unsigned*)(gp), (LAS unsigned*)(lp), 16, 0, 0)
__device__ __forceinline__ void mem_attn_wg(const bf16* P, const bf16* kmq, const bf16* vmt, bf16* abuf, int row0, int h, LAS unsigned char* ldsl, int wave, int lane) {
    const int r32 = lane & 31, hi = lane >> 5;
    const bf16* qbase = P + (size_t)row0 * LDP + MQC + h * 256;
    const unsigned qo = (unsigned)(r32 * LDP + hi * 8);
#pragma unroll
    for (int i = 0; i < 16; ++i) MA_GLDS16(kmq + (wave * 16 + i) * 512 + lane * 8, ldsl + (wave * 16 + i) * 1024);
    bf16x8 q[16];
#pragma unroll
    for (int ks = 0; ks < 8; ++ks) q[ks] = *(const bf16x8*)(qbase + qo + ks * 16);
    f32x16 s[8];
#pragma unroll
    for (int kb = 0; kb < 8; ++kb) s[kb] = f32x16{};
    float ss = 0.f;
    asm volatile("s_waitcnt vmcnt(0)" ::: "memory");
    __syncthreads();
    const LAS unsigned char* fl_ = ldsl + lane * 16;
    bf16x8 kfa[8], kfb[8];
#pragma unroll
    for (int kb = 0; kb < 8; ++kb) kfa[kb] = *(const LAS bf16x8*)(fl_ + (kb * 16 + 0) * 1024);
#pragma unroll
    for (int ks = 0; ks < 16; ++ks) {
        if (ks + 8 < 16) q[ks + 8] = *(const bf16x8*)(qbase + qo + (ks + 8) * 16);
        if (ks + 1 < 16) {
#pragma unroll
            for (int kb = 0; kb < 8; ++kb) { if (ks & 1) kfa[kb] = *(const LAS bf16x8*)(fl_ + (kb * 16 + ks + 1) * 1024); else kfb[kb] = *(const LAS bf16x8*)(fl_ + (kb * 16 + ks + 1) * 1024); } }
#pragma unroll
        for (int jj = 0; jj < 8; ++jj) { const float v_ = bf2f((unsigned short)q[ks][jj]); ss += v_ * v_; }
#pragma unroll
        for (int kb = 0; kb < 8; ++kb) s[kb] = __builtin_amdgcn_mfma_f32_32x32x16_bf16((ks & 1) ? kfb[kb] : kfa[kb], q[ks], s[kb], 0, 0, 0);
        __builtin_amdgcn_sched_barrier(0);
    }
    __syncthreads();
#pragma unroll
    for (int i = 0; i < 16; ++i) MA_GLDS16(vmt + (wave * 16 + i) * 512 + lane * 8, ldsl + (wave * 16 + i) * 1024);
    ss = half_sum(ss);
    const float rstd = __builtin_amdgcn_rsqf(ss * (1.f / 256.f) + NORM_EPS);
    const float cc = rstd * 0.0625f * LOG2E;
    float mx = s[0][0];
#pragma unroll
    for (int kb = 0; kb < 8; ++kb)
#pragma unroll
        for (int r = 0; r < 16; ++r) mx = fmaxf(mx, s[kb][r]);
    mx = half_max(mx);
    const float mL = -mx * cc; float l = 0.f;
    bf16x8 pa[16];
#pragma unroll
    for (int kb = 0; kb < 8; ++kb) {
#pragma unroll
        for (int r = 0; r < 16; ++r) { const float p = __builtin_amdgcn_exp2f(fmaf(s[kb][r], cc, mL)); s[kb][r] = p; l += p; }
        PK4(s[kb], 0, pa[2 * kb]); PK4(s[kb], 8, pa[2 * kb + 1]); }
    l = half_sum(l);
    const float linv = __builtin_amdgcn_rcpf(l);
    float rl[16];
#pragma unroll
    for (int r = 0; r < 16; ++r) rl[r] = shidx(linv, att::crow(r, hi));
    const bf16* gbase = P + (size_t)row0 * LDP + MGC + h * 256;
    bf16* obase = abuf + (size_t)row0 * DM + MIXW + h * 256;
    const unsigned go = (unsigned)(4 * hi * LDP + r32), ao = (unsigned)(4 * hi * DM + r32);
    asm volatile("s_waitcnt vmcnt(0)" ::: "memory");
    __syncthreads();
#pragma unroll 1
    for (int d0 = 0; d0 < 8; ++d0) { f32x16 o = f32x16{};
        unsigned short gv[16];
#pragma unroll
        for (int r = 0; r < 16; ++r) { const int cr = (r & 3) + 8 * (r >> 2); gv[r] = *(const unsigned short*)(gbase + (size_t)cr * LDP + go + d0 * 32); }
        bf16x8 vf[16];
#pragma unroll
        for (int ks = 0; ks < 16; ++ks) vf[ks] = *(const LAS bf16x8*)(fl_ + (d0 * 16 + ks) * 1024);
#pragma unroll
        for (int ks = 0; ks < 16; ++ks) o = __builtin_amdgcn_mfma_f32_32x32x16_bf16(pa[ks], vf[ks], o, 0, 0, 0);
#pragma unroll
        for (int r = 0; r < 16; ++r) { const int cr = (r & 3) + 8 * (r >> 2);
            const float v = o[r] * rl[r] * silu_f(bf2f(gv[r]));
            obase[(size_t)cr * DM + ao + d0 * 32] = (bf16)(cvt_pk_bf16(v, 0.f) & 0xffffu); } }
    __syncthreads();
}
#undef MA_GLDS16
__device__ __forceinline__ void fl_task(const bf16* h, const bf16* wfl, const float* ssqp, float* flb, int rowblk, LAS unsigned char* ldsl, int wave, int lane) {
    const int r32 = lane & 31, hi = lane >> 5, rb = wave & 1, kq = wave >> 1;
    const int row0 = rowblk * 64 + rb * 32;
    const bf16* ap = h + (size_t)(row0 + r32) * DM + kq * 1024 + hi * 8;
    const bf16* bp = wfl + (size_t)r32 * DM + kq * 1024 + hi * 8;
    f32x16 acc = f32x16{};
#pragma unroll 8
    for (int ks = 0; ks < 64; ++ks) { const bf16x8 a = *(const bf16x8*)(ap + ks * 16), b = *(const bf16x8*)(bp + ks * 16); acc = __builtin_amdgcn_mfma_f32_32x32x16_bf16(a, b, acc, 0, 0, 0); }
    LAS float* part = (LAS float*)ldsl;
#pragma unroll
    for (int r = 0; r < 16; ++r) part[((kq * 2 + rb) * 16 + r) * 64 + lane] = acc[r];
    __syncthreads();
    LAS float* outt = part + 4 * 2 * 16 * 64;
    if (kq == 0) {
        const float* sp = ssqp + (size_t)(row0 + r32) * 16;
        const f32x4 t0 = *(const f32x4*)sp, t1 = *(const f32x4*)(sp + 4), t2 = *(const f32x4*)(sp + 8), t3 = *(const f32x4*)(sp + 12);
        const float ssum = (((t0[0] + t0[1]) + (t0[2] + t0[3])) + ((t1[0] + t1[1]) + (t1[2] + t1[3]))) + (((t2[0] + t2[1]) + (t2[2] + t2[3])) + ((t3[0] + t3[1]) + (t3[2] + t3[3])));
        const float rstd = __builtin_amdgcn_rsqf(ssum * (1.f / DM) + NORM_EPS);
#pragma unroll
        for (int r = 0; r < 16; ++r) { const int cr = att::crow(r, hi);
            const float v = (part[((0 * 2 + rb) * 16 + r) * 64 + lane] + part[((1 * 2 + rb) * 16 + r) * 64 + lane]) + (part[((2 * 2 + rb) * 16 + r) * 64 + lane] + part[((3 * 2 + rb) * 16 + r) * 64 + lane]);
            outt[r32 * 64 + rb * 32 + cr] = v * shidx(rstd, cr); }
    }
    __syncthreads();
    { const int t = wave * 64 + lane, col = t >> 4, r4 = (t & 15) * 4;
      *(f32x4*)(flb + (size_t)col * S_ + (size_t)rowblk * 64 + r4) = *(const LAS f32x4*)(outt + col * 64 + r4); }
    __syncthreads();
}
#undef PK4

#define LAUNDER_TID() int lane; asm volatile("v_mbcnt_lo_u32_b32 %0, -1, 0\n\tv_mbcnt_hi_u32_b32 %0, -1, %0" : "=v"(lane)); const int wave = wave_s; \
                      const int tid = wave * 64 + lane; (void)tid
#define PHASE_BEGIN() ArgsP A = (ArgsP)__builtin_amdgcn_kernarg_segment_ptr(); asm volatile("" : "+s"(A)); LAUNDER_TID(); \
                      const int G = gridDim.x, bx = blockIdx.x; const int vcu = (G % 8 == 0) ? (bx % 8) * (G / 8) + bx / 8 : bx; \
                      const int NGW = G * 8, gw = vcu * 8 + wave; unsigned char* ws = A->ws; (void)NGW; (void)gw; (void)ws
#define WSP(T, off) ((T*)(ws + (off)))
__global__ void __launch_bounds__(512, 2) fwd(Args args) {
    extern __shared__ __attribute__((aligned(16))) unsigned char lds[];
    LAS unsigned char* ldsl = (LAS unsigned char*)lds;
    const int wave_s = __builtin_amdgcn_readfirstlane((int)threadIdx.x >> 6);
    { const int t0 = threadIdx.x; for (int u = t0; u < (LDS_BYTES - LDSCTL_OFF) / 4; u += 512) ((LAS unsigned*)(ldsl + LDSCTL_OFF))[u] = 0u; }
    __syncthreads();
    const int lo = args.ph_lo, hi_ph = args.ph_hi;
    if (hi_ph - lo > 1) { if (threadIdx.x == 0) (void)xb_add(&((unsigned*)(args.ws + WS_CTL) + CW_BAR)[XB_XCNT(xb_xcc_id())], 1u); }
    asm volatile("" ::: "memory");
#ifndef PH_MASK
#define PH_MASK 0x1ff
#endif
#define INK(kind, k) (((PH_MASK >> (kind)) & 1) && lo <= (k) && (k) < hi_ph)
#ifndef DUP_MASK
#define DUP_MASK 0
#endif
#define NREP(kind) (((DUP_MASK >> (kind)) & 1) ? 2 : 1)
#define SEAM(k) do { if (lo <= (k) && (k) + 1 < hi_ph) { PHASE_BEGIN(); XcdBarrier bar; bar.bar = (unsigned*)(ws + WS_CTL) + CW_BAR; bar.x = xb_xcc_id(); \
                     bar.st = (volatile LAS unsigned*)(ldsl + MISC_OFF) + 8; xcd_barrier(bar, tid == 0); } } while (0)

    if (INK(0, 0)) for (int rep = 0; rep < NREP(0); ++rep) {
        PHASE_BEGIN();
        const float* mem = A->in[1]; const float* mem_norm_g = A->in[2]; const float* w_out = A->in[4]; const float* w_mem_kv = A->in[5];
        const float* diff_w_in = A->in[8]; const float* fox_w_in = A->in[16];
        bf16* WinT = WSP(bf16, WS_WIN); bf16* WoutT = WSP(bf16, WS_WOUT); bf16* WkvT = WSP(bf16, WS_WKV); bf16* memn = WSP(bf16, WS_MEMN); float* rope = WSP(float, WS_ROPE);
        LAS float* scr = (LAS float*)(ldsl + wave * 16384);
        constexpr int I_DIFF = 64 * 448, I_FA = 64 * 384, I_FB = 64 * 64, I_FC = 64 * 8, I_FOX = I_FA + I_FB + I_FC, I_OUT = 64 * 128, I_KV = 64 * 64;
        constexpr int I_LAYER_D = I_DIFF + I_OUT + I_KV, I_LAYER_F = I_FOX + I_OUT + I_KV;
        constexpr int TOTAL = 2 * I_LAYER_D + 2 * I_LAYER_F;
        for (int it = gw; it < TOTAL; it += NGW) {
            int r = it; int l;
            if (r < I_LAYER_D) l = 0; else { r -= I_LAYER_D; if (r < I_LAYER_F) l = 1; else { r -= I_LAYER_F; if (r < I_LAYER_D) l = 2; else { r -= I_LAYER_D; l = 3; } } }
            const int j = l >> 1; const float* lng = A->in[3] + (size_t)l * DM;
            bf16* wt = WinT + (size_t)l * WROWS * DM;
            if ((l & 1) == 0) {
                if (r < I_DIFF) { tr_item(diff_w_in + (size_t)j * DM * DIFF_IN, DIFF_IN, 0, DIFF_IN, wt, 0, scr, r, 448, lane, lng); continue; } r -= I_DIFF;
            } else {
                const float* src = fox_w_in + (size_t)j * DM * FOX_IN;
                if (r < I_FA) { tr_item(src, FOX_IN, 0, 12288, wt, 0, scr, r, 384, lane, lng); continue; } r -= I_FA;
                if (r < I_FB) { tr_item(src, FOX_IN, 12312, 2048, wt, 12288, scr, r, 64, lane, lng); continue; } r -= I_FB;
                if (r < I_FC) { tr_item(src, FOX_IN, 12288, 24, wt, 14336, scr, r, 8, lane, lng); continue; } r -= I_FC;
            }
            if (r < I_OUT) { tr_item(w_out + (size_t)l * DM * DM, DM, 0, DM, WoutT + (size_t)l * DM * DM, 0, scr, r, 128, lane); continue; } r -= I_OUT;
            tr_item(w_mem_kv + (size_t)l * DM * 2048, 2048, 0, 2048, WkvT, l * 2048, scr, r, 64, lane);
        }
        for (int m = gw; m < NMEM; m += NGW) rms_row_to_bf16(mem + (size_t)m * DM, mem_norm_g, memn + (size_t)m * DM, lane);
        { const float* x0 = A->in[0]; bf16* xb = WSP(bf16, WS_H); float* ssq0 = WSP(float, WS_SSQP);
          for (int m = gw; m < S_; m += NGW) row_to_bf16_ssq(x0 + (size_t)m * DM, xb + (size_t)m * DM, ssq0 + (size_t)m * 16, lane); }
        for (int e = (vcu * 512 + tid); e < S_ * 16; e += G * 512) {
            const int s = e >> 4, i = e & 15;
            const float inv = (float)exp2(-(double)i * 1.1832230355827609);
            const float ang = (float)s * inv;
            double rev = (double)ang * 0.15915494309189535; rev -= floor(rev);
            const float rf = (float)rev;
            rope[(size_t)s * 32 + i] = __builtin_amdgcn_cosf(rf);
            rope[(size_t)s * 32 + 16 + i] = __builtin_amdgcn_sinf(rf);
        }
    }
    SEAM(0);
    if (INK(1, 1)) {
        PHASE_BEGIN();
        pg8::Gemm g{WSP(bf16, WS_MEMN), WSP(bf16, WS_WKV), NMEM * KV_SPLIT, 8192, DM / KV_SPLIT, DM}; pg8::SplitKOrder SO; SO.init(KV_SPLIT, 8192, DM / KV_SPLIT, G, bx);
        pg8::EpiF32 E{WSP(float, WS_OP), 8192};
        pg8::gemm_phase<pg8::EpiF32, pg8::SplitKOrder, true, true>(ldsl, g, SO, E, tid);
    }
    SEAM(1);

    for (int l = 0; l < DEPTH; ++l) {
        const int base = 3 + 6 * l, j = l >> 1; const bool fox = (l & 1) != 0;
        if (INK(4, base + 1)) for (int rep = 0; rep < NREP(4); ++rep) {
            PHASE_BEGIN();
            if (l == 0) {
            const float* mem_q_g = A->in[6]; const float* mem_k_g = A->in[7];
            const float* kvb = WSP(float, WS_OP); bf16* kmq = WSP(bf16, WS_KMQ); bf16* vmt = WSP(bf16, WS_VMT);
            for (int t = gw; t < 4 * 4 * NMEM; t += NGW) {
                const int key = t & 255, h = (t >> 8) & 3, l = t >> 10;
                const float* kr = kvb + (size_t)key * 8192 + l * 2048 + h * 256;
                f32x4 kx = *(const f32x4*)(kr + 4 * lane), vx = *(const f32x4*)(kr + 1024 + 4 * lane);
    #pragma unroll
                for (int sl = 1; sl < KV_SPLIT; ++sl) { kx += *(const f32x4*)(kr + (size_t)sl * NMEM * 8192 + 4 * lane); vx += *(const f32x4*)(kr + (size_t)sl * NMEM * 8192 + 1024 + 4 * lane); }
                const float ss = wave_sum((kx.x * kx.x + kx.y * kx.y) + (kx.z * kx.z + kx.w * kx.w), lane);
                const float rstd = __builtin_amdgcn_rsqf(ss * (1.f / 256.f) + NORM_EPS);
                const f32x4 gk = *(const f32x4*)(mem_k_g + l * 256 + 4 * lane), gq = *(const f32x4*)(mem_q_g + l * 256 + 4 * lane);
                u32x2 w; w.x = cvt_pk_bf16(kx.x * rstd * gk.x * gq.x, kx.y * rstd * gk.y * gq.y); w.y = cvt_pk_bf16(kx.z * rstd * gk.z * gq.z, kx.w * rstd * gk.w * gq.w);
                { const int d = 4 * lane;
                  *(u32x2*)(kmq + (size_t)(l * 4 + h) * 65536 + ((((key >> 5) * 16 + (d >> 4)) * 64 + ((d >> 3) & 1) * 32 + (key & 31)) * 8 + (d & 7))) = w; }
                bf16* vb = vmt + (size_t)(l * 4 + h) * 65536; const float vv[4] = {vx.x, vx.y, vx.z, vx.w};
    #pragma unroll
                for (int e = 0; e < 4; ++e) { const int d = 4 * lane + e;
                    vb[(((d >> 5) * 16 + (key >> 4)) * 64 + ((key >> 3) & 1) * 32 + (d & 31)) * 8 + (key & 7)] = (bf16)(cvt_pk_bf16(vv[e], 0.f) & 0xffffu); }
            }
            }
            const int N = DIFF_IN;
            if (fox) for (int rbk = 4 * (8 * (bx % 8) + ((bx / 8) % 8)) + (bx >> 6); rbk < S_ / 64; rbk += S_ / 64)
                fl_task(WSP(bf16, WS_H), WSP(bf16, WS_WIN) + ((size_t)l * WROWS + DIFF_IN) * DM, WSP(float, WS_SSQP) + (size_t)l * S_ * 16, WSP(float, WS_FL), rbk, ldsl, wave, lane);
            pg8::Gemm g{WSP(bf16, WS_H), WSP(bf16, WS_WIN) + (size_t)l * WROWS * DM, S_, N, DM, DM}; pg8::InprojOrder SO; SO.init(S_, N, G, bx);
            SO.dBA = (long)((const char*)g.Bt - (const char*)g.A); SO.v0 = V_PN0; SO.v1 = V_PN1;
            LAS float* rtab = (LAS float*)(ldsl + RING_BYTES + 8192);
            if (tid < 256) { const int pm0 = 8 * (bx % 8) + ((bx / 8) % 8); const float* sp = WSP(float, WS_SSQP) + ((size_t)l * S_ + (size_t)pm0 * 256 + tid) * 16;
                const f32x4 t0 = *(const f32x4*)sp, t1 = *(const f32x4*)(sp + 4), t2 = *(const f32x4*)(sp + 8), t3 = *(const f32x4*)(sp + 12);
                const float ssum = (((t0[0] + t0[1]) + (t0[2] + t0[3])) + ((t1[0] + t1[1]) + (t1[2] + t1[3]))) + (((t2[0] + t2[1]) + (t2[2] + t2[3])) + ((t3[0] + t3[1]) + (t3[2] + t3[3])));
                rtab[tid] = __builtin_amdgcn_rsqf(ssum * (1.f / DM) + NORM_EPS); }
            __syncthreads();
            pg8::EpiP E{WSP(bf16, WS_P), LDP, WSP(float, WS_FL), -1, WSP(float, WS_SSQP) + (size_t)l * S_ * 16,
                        (LAS float*)(ldsl + RING_BYTES), (fox ? A->in[18] : A->in[9]) + j * 128, (fox ? A->in[19] : A->in[10]) + j * 128, WSP(float, WS_ROPE), fox ? 0 : 1, WSP(bf16, WS_VT), rtab};
            pg8::gemm_phase<pg8::EpiP, pg8::InprojOrder, true, true>(ldsl, g, SO, E, tid);
        }
        SEAM(base + 1);
        if (INK(5, base + 2) && fox) {
            PHASE_BEGIN();
            bf16* Pb = WSP(bf16, WS_P);
#ifndef POST_PARTS
#define POST_PARTS 7
#endif
            if ((POST_PARTS & 1) && fox && vcu < 24) for (int rep = 0; rep < NREP(11); ++rep) {
                const int h = vcu; const float* flb = WSP(float, WS_FL); float* dk = WSP(float, WS_DK);
                const float bfv = A->in[17][j * 24 + h];
                float v[32]; float run = 0.f;
#pragma unroll
                for (int i = 0; i < 32; ++i) { const float z = flb[(size_t)h * S_ + tid * 32 + i] + bfv;
                    const float az = fabsf(z); const float lf = fminf(z, 0.f) - log1pf(__expf(-az)); run += lf; v[i] = run; }
                float inc = run;
#pragma unroll
                for (int o = 1; o < 64; o <<= 1) { const float t = shidx(inc, lane >= o ? lane - o : lane); if (lane >= o) inc += t; }
                LAS float* wt = (LAS float*)(ldsl + 1024);
                if (lane == 63) wt[wave] = inc;
                __syncthreads();
                float off = inc - run;
                for (int w = 0; w < wave; ++w) off += wt[w];
                float* dst = dk + (size_t)h * S_ + tid * 32;
#pragma unroll
                for (int i = 0; i < 32; i += 4) { f32x4 o4 = {-(off + v[i]) * LOG2E, -(off + v[i + 1]) * LOG2E, -(off + v[i + 2]) * LOG2E, -(off + v[i + 3]) * LOG2E}; *(f32x4*)(dst + i) = o4; }
                asm volatile("s_waitcnt vmcnt(0)" ::: "memory");
                __syncthreads();
                if (tid < 64) {
                    const float* qg_ = A->in[18] + j * 128; const float* kg_ = A->in[19] + j * 128; float mq = 0.f, mk_ = 0.f;
                    for (int i = 0; i < 128; ++i) { mq = fmaxf(mq, fabsf(qg_[i])); mk_ = fmaxf(mk_, fabsf(kg_[i])); }
                    const float B = 128.f * mq * mk_ * QSCALE * 1.02f, thr = 2.f * B + 40.f;
                    const int qb = tid; const float* dkh = dk + (size_t)h * S_;
                    const float ref = __builtin_nontemporal_load(dkh + 256 * qb) - thr;
                    int lo_ = 0, hi_ = 4 * qb;
                    while (lo_ < hi_) { const int mid = (lo_ + hi_) >> 1; if (__builtin_nontemporal_load(dkh + 64 * mid + 63) >= ref) hi_ = mid; else lo_ = mid + 1; }
                    WSP(int, WS_JLO)[h * 64 + qb] = lo_;
                }
                __syncthreads();
            }
            if (vcu >= 24) {
                const bf16* kmq = WSP(bf16, WS_KMQ); const bf16* vmt = WSP(bf16, WS_VMT); bf16* abuf = WSP(bf16, WS_A);
                for (int t = vcu; t < (S_ / 256) * 4; t += G) {
                    const int h = t & 3, row0 = (t >> 2) * 256 + wave * 32;
                    mem_attn_wg(Pb, kmq + (size_t)(l * 4 + h) * 65536, vmt + (size_t)(l * 4 + h) * 65536, abuf, row0, h, ldsl, wave, lane);
                }
            }
        }
        if (fox) SEAM(base + 2);
        if (INK(6, base + 3)) for (int rep = 0; rep < NREP(6); ++rep) {
            {
                PHASE_BEGIN();
                {
                    const bf16* Pb = WSP(bf16, WS_P); const bf16* kmq = WSP(bf16, WS_KMQ); const bf16* vmt = WSP(bf16, WS_VMT); bf16* abuf = WSP(bf16, WS_A);
                    if (!fox || vcu < 24) for (int t = vcu; t < (S_ / 256) * 4; t += G) {
                        const int h = t & 3, row0 = (t >> 2) * 256 + wave * 32;
                        mem_attn_wg(Pb, kmq + (size_t)(l * 4 + h) * 65536, vmt + (size_t)(l * 4 + h) * 65536, abuf, row0, h, ldsl, wave, lane);
                    }
                }
            }
            if (fox) { PHASE_BEGIN(); att2::attn2_phase<1, true>(WSP(bf16, WS_P), WSP(bf16, WS_VT), WSP(float, WS_DK), WSP(int, WS_JLO), (unsigned*)(ws + WS_CTL) + CW_QCTR + 64 * j, WSP(bf16, WS_A), WSP(float, WS_OP), (char*)lds, ldsl, vcu, G, tid); }
            else { PHASE_BEGIN();
                const float* lam_q1 = A->in[11]; const float* lam_k1 = A->in[12]; const float* lam_q2 = A->in[13]; const float* lam_k2 = A->in[14];
                const float lam_init = (l == 0) ? 0.2f : 0.4707130183435842f;
                float s1 = lam_q1[j * 128 + lane] * lam_k1[j * 128 + lane] + lam_q1[j * 128 + 64 + lane] * lam_k1[j * 128 + 64 + lane];
                float s2 = lam_q2[j * 128 + lane] * lam_k2[j * 128 + lane] + lam_q2[j * 128 + 64 + lane] * lam_k2[j * 128 + 64 + lane];
                s1 = wave_sum(s1, lane); s2 = wave_sum(s2, lane);
                const float lam = __expf(s1) - __expf(s2) + lam_init;
                att2::attn2_phase<2, false>(WSP(bf16, WS_P), WSP(bf16, WS_VT), WSP(float, WS_DK), WSP(int, WS_JLO), (unsigned*)(ws + WS_CTL) + CW_QCTR, WSP(bf16, WS_A), WSP(float, WS_OP), (char*)lds, ldsl, vcu, G, tid, __uint_as_float(__builtin_amdgcn_readfirstlane(__float_as_uint(lam))), 1.f - lam_init, A->in[15] + j * 256); }
        }
        SEAM(base + 3);
        if (INK(7, base + 4) && !fox) for (int rep = 0; rep < NREP(7); ++rep) {
            PHASE_BEGIN();
            const float* lam_q1 = A->in[11]; const float* lam_k1 = A->in[12]; const float* lam_q2 = A->in[13]; const float* lam_k2 = A->in[14]; const float* subln_g = A->in[15];
            const bf16* opart = WSP(bf16, WS_OP); const bf16* Pb = WSP(bf16, WS_P); bf16* abuf = WSP(bf16, WS_A);
            const float lam_init = (l == 0) ? 0.2f : 0.4707130183435842f;
            float s1 = lam_q1[j * 128 + lane] * lam_k1[j * 128 + lane] + lam_q1[j * 128 + 64 + lane] * lam_k1[j * 128 + 64 + lane];
            float s2 = lam_q2[j * 128 + lane] * lam_k2[j * 128 + lane] + lam_q2[j * 128 + 64 + lane] * lam_k2[j * 128 + 64 + lane];
            s1 = wave_sum(s1, lane); s2 = wave_sum(s2, lane);
            const float lam = __expf(s1) - __expf(s2) + lam_init;
            const f32x4 sg = *(const f32x4*)(subln_g + j * 256 + 4 * lane);
            const float post = 1.f - lam_init;
            const int l31 = lane & 31, hw = lane >> 5;
            const f32x4 sga = *(const f32x4*)(subln_g + j * 256 + 8 * l31), sgb = *(const f32x4*)(subln_g + j * 256 + 8 * l31 + 4);
            for (int t0 = gw; t0 < S_ * 4; t0 += 8 * NGW) {
                u32x4 a0[4], a1[4], gq[4];
#pragma unroll
                for (int u = 0; u < 4; ++u) { const int t = t0 + (2 * u + hw) * NGW, row = t >> 2, h = 8 + (t & 3); const size_t oo = (size_t)row * MIXW + h * 256 + 8 * l31;
                    a0[u] = *(const u32x4*)(opart + oo); a1[u] = *(const u32x4*)(opart + (size_t)S_ * MIXW + oo); gq[u] = *(const u32x4*)(Pb + (size_t)row * LDP + GC + h * 256 + 8 * l31); }
#pragma unroll
                for (int u = 0; u < 4; ++u) { const int t = t0 + (2 * u + hw) * NGW, row = t >> 2, h = 8 + (t & 3);
                    const f32x4 p0 = {bflo(a0[u].x), bfhi(a0[u].x), bflo(a0[u].y), bfhi(a0[u].y)}, p1 = {bflo(a0[u].z), bfhi(a0[u].z), bflo(a0[u].w), bfhi(a0[u].w)};
                    const f32x4 q0 = {bflo(a1[u].x), bfhi(a1[u].x), bflo(a1[u].y), bfhi(a1[u].y)}, q1 = {bflo(a1[u].z), bfhi(a1[u].z), bflo(a1[u].w), bfhi(a1[u].w)};
                    const f32x4 d0 = p0 - lam * q0, d1 = p1 - lam * q1;
                    float ss = ((d0.x * d0.x + d0.y * d0.y) + (d0.z * d0.z + d0.w * d0.w)) + ((d1.x * d1.x + d1.y * d1.y) + (d1.z * d1.z + d1.w * d1.w));
#pragma unroll
                    for (int o = 1; o < 32; o <<= 1) ss += shx(ss, o, lane);
                    const float r = __builtin_amdgcn_rsqf(ss * (1.f / 256.f) + NORM_EPS) * post;
                    u32x4 w; w.x = cvt_pk_bf16(d0.x * r * sga.x * silu_f(bflo(gq[u].x)), d0.y * r * sga.y * silu_f(bfhi(gq[u].x)));
                    w.y = cvt_pk_bf16(d0.z * r * sga.z * silu_f(bflo(gq[u].y)), d0.w * r * sga.w * silu_f(bfhi(gq[u].y)));
                    w.z = cvt_pk_bf16(d1.x * r * sgb.x * silu_f(bflo(gq[u].z)), d1.y * r * sgb.y * silu_f(bfhi(gq[u].z)));
                    w.w = cvt_pk_bf16(d1.z * r * sgb.z * silu_f(bflo(gq[u].w)), d1.w * r * sgb.w * silu_f(bfhi(gq[u].w)));
                    *(u32x4*)(abuf + (size_t)row * DM + h * 256 + 8 * l31) = w; }
            }
        }
        if (!fox) SEAM(base + 4);
        if (INK(8, base + 5)) {
            PHASE_BEGIN();
            pg8::Gemm g{WSP(bf16, WS_A), WSP(bf16, WS_WOUT) + (size_t)l * DM * DM, S_, DM, DM, DM}; pg8::StaticOrder SO; SO.init(S_, DM, G, bx);
            const bool lastl = l + 1 == DEPTH;
            pg8::EpiRes E{(l == 0) ? A->in[0] : (const float*)nullptr, WSP(bf16, WS_H), lastl ? A->out : (float*)nullptr, DM,
                          lastl ? (bf16*)nullptr : WSP(bf16, WS_H), WSP(float, WS_SSQP) + (size_t)(lastl ? 0 : l + 1) * S_ * 16, (LAS float*)(ldsl + RING_BYTES)};
            pg8::gemm_phase<pg8::EpiRes, pg8::StaticOrder, false, true>(ldsl, g, SO, E, tid);
        }
        if (l + 1 < DEPTH && MK_ONE_LAUNCH) {
            if (lo <= base + 5 && base + 6 < hi_ph) { PHASE_BEGIN();
                const int pm0 = 8 * (bx % 8) + ((bx / 8) % 8);
                unsigned* ctl = (unsigned*)(ws + WS_CTL); unsigned* qc = ctl + CW_QUAD + l * 64 + pm0;
                asm volatile("s_waitcnt vmcnt(0)" ::: "memory"); __syncthreads();
                if (tid == 0) {
                    __builtin_amdgcn_fence(__ATOMIC_RELEASE, "agent"); asm volatile("s_waitcnt vmcnt(0)" ::: "memory");
                    (void)xb_add(qc, 1u);
                    XB_SPIN(xb_ld(qc) < 4u, ctl + CW_BAR);
                    __builtin_amdgcn_fence(__ATOMIC_ACQUIRE, "agent"); asm volatile("s_waitcnt vmcnt(0)" ::: "memory"); }
                __syncthreads(); }
        } else SEAM(base + 5);
    }
#undef INK
#undef SEAM
}

extern "C" void kernel_launch(void* const* d_in, const int* in_sizes, int n_in, void* d_out, int out_size, void* d_ws, size_t ws_size, hipStream_t stream) {
    static int grid = 0;
    if (grid == 0) {
        if (n_in != 20 || out_size != S_ * DM || ws_size < WS_END) { fprintf(stderr, "kernel_launch: unexpected shapes (n_in %d out %d ws %zu need %zu)\n", n_in, out_size, ws_size, (size_t)WS_END); grid = -1; return; }
        int dev = 0, cus = 0;
        if (hipGetDevice(&dev) != hipSuccess || hipDeviceGetAttribute(&cus, hipDeviceAttributeMultiprocessorCount, dev) != hipSuccess) { grid = -1; return; }
        if (hipFuncSetAttribute((const void*)fwd, hipFuncAttributeMaxDynamicSharedMemorySize, LDS_BYTES) != hipSuccess) { fprintf(stderr, "kernel_launch: hipFuncSetAttribute failed\n"); grid = -1; return; }
        int per_cu = 0;
        (void)hipOccupancyMaxActiveBlocksPerMultiprocessor(&per_cu, (const void*)fwd, 512, LDS_BYTES);
        (void)hipGetLastError();
        grid = cus;
        if (grid > 256) grid = 256;
        if (grid != 256) { fprintf(stderr, "kernel_launch: this kernel is laid out for 256 CUs (found %d)\n", cus); grid = -1; return; }
    }
    if (grid < 0) return;
    (void)hipMemsetAsync((char*)d_ws + WS_CTL, 0, CTL_ZERO_BYTES, stream);
    Args a{};
    for (int i = 0; i < 20; ++i) a.in[i] = (const float*)d_in[i];
    a.out = (float*)d_out; a.ws = (unsigned char*)d_ws;
#if MK_ONE_LAUNCH
    a.ph_lo = 0; a.ph_hi = N_PHASES;
    hipLaunchKernelGGL(fwd, dim3(grid), dim3(512), LDS_BYTES, stream, a);
#else
    for (int p = 0; p < N_PHASES; ++p) {
        const int l = (p - 3) / 6, k = (p - 3) % 6;
        if (p >= 3 && k == 4 && (l & 1)) continue;
        a.ph_lo = p; a.ph_hi = p + 1;
        hipLaunchKernelGGL(fwd, dim3(grid), dim3(512), LDS_BYTES, stream, a);
    }
#endif
}
```

```cpp
#include <hip/hip_runtime.h>
#include <cstdio>
#include <cstdint>

#ifndef DUP_MASK
#define DUP_MASK 0x00
#endif
#ifndef MK_ONE_LAUNCH
#define MK_ONE_LAUNCH 1
#endif

#define GAS __attribute__((address_space(1)))
#define LAS __attribute__((address_space(3)))

constexpr int S_ = 16384, DM = 4096, DEPTH = 4, NMEM = 256;
constexpr int MIXW = 3072, MEMW = 1024, HD = 128;
constexpr int WROWS = 14592;
constexpr int LDP = 11264;
constexpr int QC = 0, KC = 3072, GC = 6144, MQC = 9216, MGC = 10240;
constexpr int V_PN0 = 24, V_PN1 = 36, FL_PN = 56;
constexpr int DIFF_IN = 14336, FOX_IN = 14360;
constexpr float NORM_EPS = 1e-6f;
constexpr float LOG2E = 1.4426950408889634f;
constexpr float QSCALE = 1.4426950408889634f * 0.08838834764831845f;

typedef unsigned short bf16;
typedef short bf16x8 __attribute__((ext_vector_type(8)));
typedef short s16x4 __attribute__((ext_vector_type(4)));
typedef float f32x16 __attribute__((ext_vector_type(16)));
typedef float f32x4 __attribute__((ext_vector_type(4)));
typedef float f32x2 __attribute__((ext_vector_type(2)));
typedef unsigned u32x4 __attribute__((ext_vector_type(4)));
typedef unsigned u32x2 __attribute__((ext_vector_type(2)));

constexpr size_t MiB = 1u << 20;
constexpr size_t al(size_t x) { return (x + MiB - 1) / MiB * MiB; }
constexpr size_t WS_CTL = 0, CTL_ZERO_BYTES = 1 * MiB;
constexpr size_t SZ_WIN = (size_t)WROWS * DM * 2;
constexpr size_t WS_WIN = 1 * MiB;
constexpr size_t WS_WOUT = WS_WIN + al(4 * SZ_WIN);
constexpr size_t WS_WKV = WS_WOUT + 4 * (size_t)DM * DM * 2;
constexpr size_t WS_MEMN = WS_WKV + 4 * (size_t)2048 * DM * 2;
constexpr size_t WS_KV = WS_MEMN + (size_t)NMEM * DM * 2;
constexpr size_t WS_KMQ = WS_KV + (size_t)NMEM * 8192 * 4;
constexpr size_t WS_VMT = WS_KMQ + (size_t)16 * 256 * 256 * 2;
constexpr size_t WS_ROPE = WS_VMT + (size_t)16 * 256 * 256 * 2;
constexpr size_t WS_H = WS_ROPE + (size_t)S_ * 32 * 4;
constexpr size_t WS_P = WS_H + (size_t)S_ * DM * 2;
constexpr size_t WS_A = WS_P + al((size_t)S_ * LDP * 2);
constexpr size_t WS_DK = WS_A + (size_t)S_ * DM * 2;
constexpr size_t WS_FL = WS_DK + al((size_t)24 * S_ * 4);
constexpr size_t WS_OP = WS_FL + (size_t)S_ * 32 * 4;
constexpr size_t WS_VT = WS_OP + (size_t)2 * S_ * MIXW * 4;
constexpr size_t WS_SSQP = WS_VT + (size_t)MIXW * S_ * 2;
constexpr size_t WS_END = WS_SSQP + (size_t)DEPTH * S_ * 16 * 4;
constexpr int CW_BAR = 4096;
constexpr int CW_QUAD = 8192 + 4096;
constexpr int CW_QCTR = 8192;
constexpr size_t WS_JLO = WS_CTL + 128 * 1024;
constexpr size_t WS_SSQ = WS_CTL + 256 * 1024;

constexpr int RING_BYTES = 131072;
constexpr int LDS_BYTES = 155648;
constexpr int LDSCTL_OFF = LDS_BYTES - 512, MISC_OFF = LDSCTL_OFF + 320;

#define LDS_WAIT() asm volatile("s_waitcnt lgkmcnt(0)" ::: "memory")
#define VM_WAIT() asm volatile("s_waitcnt vmcnt(0)" ::: "memory")
__device__ __forceinline__ unsigned cvt_pk_bf16(float lo, float hi) { unsigned r; asm volatile("v_cvt_pk_bf16_f32 %0, %1, %2" : "=v"(r) : "v"(lo), "v"(hi)); return r; }
__device__ __forceinline__ float bf2f(unsigned short b) { return __uint_as_float(((unsigned)b) << 16); }
__device__ __forceinline__ float bflo(unsigned w) { return __uint_as_float(w << 16); }
__device__ __forceinline__ float bfhi(unsigned w) { return __uint_as_float(w & 0xffff0000u); }
__device__ __forceinline__ float shx(float v, int mask, int lane) { return __int_as_float(__builtin_amdgcn_ds_bpermute((lane ^ mask) << 2, __float_as_int(v))); }
__device__ __forceinline__ float shidx(float v, int src) { return __int_as_float(__builtin_amdgcn_ds_bpermute(src << 2, __float_as_int(v))); }
__device__ __forceinline__ float half_sum(float v) { auto rr = __builtin_amdgcn_permlane32_swap(__float_as_uint(v), __float_as_uint(v), false, false); return __uint_as_float(rr[0]) + __uint_as_float(rr[1]); }
__device__ __forceinline__ float half_max(float v) { auto rr = __builtin_amdgcn_permlane32_swap(__float_as_uint(v), __float_as_uint(v), false, false); return fmaxf(__uint_as_float(rr[0]), __uint_as_float(rr[1])); }
__device__ __forceinline__ float wave_sum(float v, int lane) {
#pragma unroll
    for (int o = 1; o < 32; o <<= 1) v += shx(v, o, lane);
    return half_sum(v);
}
__device__ __forceinline__ float silu_f(float x) { return x * __builtin_amdgcn_rcpf(1.f + __builtin_amdgcn_exp2f(-x * LOG2E)); }

namespace pg8 {
typedef unsigned short bf16_t;
constexpr int BM = 256, BK = 64, HALF = 128, HTB = HALF * BK * 2, STAGE_BYTES = 8 * HTB, NXCD = 8, WGM = 8;
__host__ __device__ __forceinline__ int lds_byte(int r, int c) { const int st = (r >> 4) * 2 + (c >> 5), rr = r & 15, cc = c & 31, ob = rr * 64 + cc * 2; return st * 1024 + (ob ^ (((ob >> 9) & 1) << 5)); }
__host__ __device__ __forceinline__ void stage_rc(int b, int& R, int& C) { const int st = b / 1024, sb = b % 1024, swz = sb ^ (((sb >> 9) & 1) << 5); R = (st >> 1) * 16 + swz / 64; C = (st & 1) * 32 + (swz % 64) / 2; }
__host__ __device__ __forceinline__ int perm32(int rho) { const int n = rho >> 4, i = rho & 15; return 8 * (i >> 2) + 4 * n + (i & 3); }
struct Unit { int pm, pn; };
struct Gemm { const bf16_t* A; const bf16_t* Bt; int M, N, K; int ld; };
struct StaticOrder {
    int nM, nN, nwg, G, c;
    __host__ __device__ void init(int M, int N, int G_, int c_) { nM = M / BM; nN = N / BM; nwg = nM * nN; G = G_; c = c_; }
    __host__ __device__ bool next(int i, Unit& u) const {
        const long L = (long)i * G + c; if (L >= nwg) return false;
        int wgid = (int)L; { const int q = nwg / NXCD, r = nwg % NXCD, xcd = wgid % NXCD, off = wgid / NXCD; wgid = (xcd < r ? xcd * (q + 1) : r * (q + 1) + (xcd - r) * q) + off; }
        const int nig = WGM * nN, gid = wgid / nig, fm = gid * WGM, gsz = (nM - fm) < WGM ? (nM - fm) : WGM;
        u.pm = fm + ((wgid % nig) % gsz); u.pn = (wgid % nig) / gsz; return true;
    }
    __device__ __forceinline__ void a_ready(const Unit&) const {}
    __device__ __forceinline__ void done(const Unit&) const {}
    __device__ __forceinline__ size_t offA(const Unit& u, size_t tstep) const { return (size_t)u.pm * tstep; }
    __device__ __forceinline__ size_t offB(const Unit& u, size_t tstep) const { return (size_t)u.pn * tstep; }
};
struct SplitKOrder {
    int nS, nN, G, c, K;
    __device__ void init(int nS_, int N, int K_, int G_, int c_) { nS = nS_; nN = N / BM; K = K_; G = G_; c = c_; }
    __device__ bool next(int i, Unit& u) const { const int L = i * G + c; if (L >= nS * nN) return false; u.pm = L % nS; u.pn = L / nS; return true; }
    __device__ __forceinline__ void a_ready(const Unit&) const {}
    __device__ __forceinline__ void done(const Unit&) const {}
    __device__ __forceinline__ size_t offA(const Unit& u, size_t) const { return (size_t)u.pm * K * 2; }
    __device__ __forceinline__ size_t offB(const Unit& u, size_t tstep) const { return (size_t)u.pn * tstep + (size_t)u.pm * K * 2; }
};
struct InprojOrder : StaticOrder {
    long dBA; int v0, v1;
    __device__ __forceinline__ size_t offA(const Unit& u, size_t tstep) const { return (u.pn >= v0 && u.pn < v1) ? (size_t)(dBA + (long)((size_t)u.pn * tstep)) : (size_t)u.pm * tstep; }
    __device__ __forceinline__ size_t offB(const Unit& u, size_t tstep) const { return (u.pn >= v0 && u.pn < v1) ? (size_t)(-dBA + (long)((size_t)u.pm * tstep)) : (size_t)u.pn * tstep; }
};
struct EpiP {
    static constexpr bool PERM = true, AFTER_DRAIN = false;
    bf16_t* O; int ldc; float* fl; int fl_pn; const float* ssq;
    LAS float* tab; const float* qg; const float* kg; const float* rope; int do_rope; bf16_t* vt; const LAS float* rtab;
    __device__ __forceinline__ void operator()(const f32x4 (&acc)[2][2][4][2], const Unit& u, int wr, int wc, int fr, int fq) const {
        if (u.pn >= V_PN0 && u.pn < V_PN1) {
            const int vr0 = (u.pn - V_PN0) * BM + wr * 64 + fr, t0 = wc * 32 + 8 * fq;
            f32x4 ra[2], rb[2];
#pragma unroll
            for (int bj = 0; bj < 2; ++bj) { ra[bj] = *(const LAS f32x4*)(rtab + t0 + bj * HALF); rb[bj] = *(const LAS f32x4*)(rtab + t0 + bj * HALF + 4); }
#pragma unroll
            for (int ai = 0; ai < 2; ++ai)
#pragma unroll
                for (int m = 0; m < 4; ++m) {
                    bf16_t* rp = vt + (size_t)(vr0 + ai * HALF + m * 16) * S_ + (size_t)u.pm * BM + wc * 32 + 16 * (fq & 1) + 4 * (fq >> 1);
#pragma unroll
                    for (int bj = 0; bj < 2; ++bj) { const f32x4 v0 = acc[ai][bj][m][0] * ra[bj], v1 = acc[ai][bj][m][1] * rb[bj];
                        u32x2 w0, w1; w0.x = cvt_pk_bf16(v0[0], v0[1]); w0.y = cvt_pk_bf16(v0[2], v0[3]); w1.x = cvt_pk_bf16(v1[0], v1[1]); w1.y = cvt_pk_bf16(v1[2], v1[3]);
                        *(u32x2*)(rp + bj * HALF) = w0; *(u32x2*)(rp + bj * HALF + 8) = w1; } }
            return;
        }
        const int row0 = u.pm * BM + wr * 64 + fr;
        float rs[2][4];
#pragma unroll
        for (int ai = 0; ai < 2; ++ai)
#pragma unroll
            for (int m = 0; m < 4; ++m) rs[ai][m] = rtab[wr * 64 + fr + ai * HALF + m * 16];
        if (u.pn == fl_pn) {
            if (wc == 0) {
#pragma unroll
                for (int ai = 0; ai < 2; ++ai)
#pragma unroll
                    for (int m = 0; m < 4; ++m) { float* rp = fl + (size_t)(row0 + ai * HALF + m * 16) * 32 + 8 * fq;
                        *(f32x4*)(rp) = acc[ai][0][m][0] * rs[ai][m]; *(f32x4*)(rp + 4) = acc[ai][0][m][1] * rs[ai][m]; }
            }
            return;
        }
        const int col0 = u.pn * BM + wc * 32 + 8 * fq;
        if (u.pn < 24) {
            const int lane = fq * 16 + fr; const bool isq = u.pn < 12;
            int frq = fr; asm volatile("" : "+v"(frq));
            const float* gp = (isq ? qg : kg) + wc * 32 + 8 * fq;
            const f32x4 g0 = *(const f32x4*)gp, g1 = *(const f32x4*)(gp + 4);
#pragma unroll
            for (int ai = 0; ai < 2; ++ai)
#pragma unroll
                for (int m = 0; m < 4; ++m)
#pragma unroll
                    for (int bj = 0; bj < 2; ++bj) { const f32x4 a = acc[ai][bj][m][0] * rs[ai][m], b = acc[ai][bj][m][1] * rs[ai][m];
                        float sp = ((a[0] * a[0] + a[1] * a[1]) + (a[2] * a[2] + a[3] * a[3])) + ((b[0] * b[0] + b[1] * b[1]) + (b[2] * b[2] + b[3] * b[3]));
                        sp += shx(sp, 16, lane); sp = half_sum(sp);
                        if (fq == 0) tab[((((ai * 2 + wr) * 64 + m * 16 + frq) * 2 + bj) * 4) + wc] = sp; }
            asm volatile("s_waitcnt lgkmcnt(0)" ::: "memory"); __builtin_amdgcn_s_barrier(); asm volatile("" ::: "memory");
            const float hs = isq ? QSCALE : 1.f;
#pragma unroll
            for (int ai = 0; ai < 2; ++ai)
#pragma unroll
                for (int m = 0; m < 4; ++m) { const int row = row0 + ai * HALF + m * 16; bf16_t* rowp = O + (size_t)row * ldc + col0;
                    f32x4 y0[2], y1[2];
#pragma unroll
                    for (int bj = 0; bj < 2; ++bj) { const f32x4 t = *(const LAS f32x4*)(tab + ((((ai * 2 + wr) * 64 + m * 16 + fr) * 2 + bj) * 4));
                        const float rh = __builtin_amdgcn_rsqf(((t[0] + t[1]) + (t[2] + t[3])) * (1.f / 128.f) + NORM_EPS) * hs * rs[ai][m];
                        y0[bj] = acc[ai][bj][m][0] * rh * g0; y1[bj] = acc[ai][bj][m][1] * rh * g1; }
                    if (do_rope && wc == 0) {
                        const float* rp = rope + (size_t)row * 32 + 8 * (fq & 1);
                        const f32x4 c0 = *(const f32x4*)rp, c1 = *(const f32x4*)(rp + 4), s0 = *(const f32x4*)(rp + 16), s1 = *(const f32x4*)(rp + 20);
                        const float sgn = (fq & 2) ? 1.f : -1.f;
#pragma unroll
                        for (int bj = 0; bj < 2; ++bj)
#pragma unroll
                            for (int e = 0; e < 4; ++e) {
                                { auto rr = __builtin_amdgcn_permlane32_swap(__float_as_uint(y0[bj][e]), __float_as_uint(y0[bj][e]), false, false);
                                  const float oth = __uint_as_float((fq & 2) ? rr[0] : rr[1]); y0[bj][e] = y0[bj][e] * c0[e] + sgn * oth * s0[e]; }
                                { auto rr = __builtin_amdgcn_permlane32_swap(__float_as_uint(y1[bj][e]), __float_as_uint(y1[bj][e]), false, false);
                                  const float oth = __uint_as_float((fq & 2) ? rr[0] : rr[1]); y1[bj][e] = y1[bj][e] * c1[e] + sgn * oth * s1[e]; } }
                    }
#pragma unroll
                    for (int bj = 0; bj < 2; ++bj) { u32x4 w; w.x = cvt_pk_bf16(y0[bj][0], y0[bj][1]); w.y = cvt_pk_bf16(y0[bj][2], y0[bj][3]); w.z = cvt_pk_bf16(y1[bj][0], y1[bj][1]); w.w = cvt_pk_bf16(y1[bj][2], y1[bj][3]);
                        *(u32x4*)(rowp + bj * HALF) = w; } }
            return;
        }
        const int colp = col0 - (V_PN1 - V_PN0) * BM;
#pragma unroll
        for (int ai = 0; ai < 2; ++ai)
#pragma unroll
            for (int m = 0; m < 4; ++m) { bf16_t* rowp = O + (size_t)(row0 + ai * HALF + m * 16) * ldc + colp;
#pragma unroll
                for (int bj = 0; bj < 2; ++bj) { const f32x4 v0 = acc[ai][bj][m][0] * rs[ai][m], v1 = acc[ai][bj][m][1] * rs[ai][m];
                    u32x4 w; w.x = cvt_pk_bf16(v0[0], v0[1]); w.y = cvt_pk_bf16(v0[2], v0[3]); w.z = cvt_pk_bf16(v1[0], v1[1]); w.w = cvt_pk_bf16(v1[2], v1[3]);
                    *(u32x4*)(rowp + bj * HALF) = w; } }
    }
};
struct EpiF32 {
    static constexpr bool PERM = false, AFTER_DRAIN = false;
    float* C; int ldc;
    __device__ __forceinline__ void operator()(const f32x4 (&acc)[2][2][4][2], const Unit& u, int wr, int wc, int fr, int fq) const {
        const int row0 = u.pm * BM + wr * 64 + fr, col0 = u.pn * BM + wc * 32 + 4 * fq;
#pragma unroll
        for (int ai = 0; ai < 2; ++ai)
#pragma unroll
            for (int m = 0; m < 4; ++m) { float* rowp = C + (size_t)(row0 + ai * HALF + m * 16) * ldc + col0;
#pragma unroll
                for (int bj = 0; bj < 2; ++bj)
#pragma unroll
                    for (int n = 0; n < 2; ++n) *(f32x4*)(rowp + bj * HALF + n * 16) = acc[ai][bj][m][n]; }
    }
};
struct EpiRes {
    static constexpr bool PERM = true, AFTER_DRAIN = false;
    const float* xin_f; const bf16_t* xin_b; float* out; int ldc; bf16_t* xb; float* ssq; LAS float* tab;
    __device__ __forceinline__ void operator()(const f32x4 (&acc)[2][2][4][2], const Unit& u, int wr, int wc, int fr, int fq) const {
        const int row0 = u.pm * BM + wr * 64 + fr, col0 = u.pn * BM + wc * 32 + 8 * fq;
        const int lane = fq * 16 + fr;
        auto finish = [&](int g, const f32x4 (&xi)[4]) {
            const int ai = g >> 2, m = g & 3; const int row = row0 + ai * HALF + m * 16; const size_t off = (size_t)row * ldc + col0;
            float sq = 0.f;
#pragma unroll
            for (int bj = 0; bj < 2; ++bj) { const f32x4 y0 = xi[bj * 2] + acc[ai][bj][m][0], y1 = xi[bj * 2 + 1] + acc[ai][bj][m][1];
                if (out) { *(f32x4*)(out + off + bj * HALF) = y0; *(f32x4*)(out + off + bj * HALF + 4) = y1; }
                if (xb) { u32x4 w; w.x = cvt_pk_bf16(y0[0], y0[1]); w.y = cvt_pk_bf16(y0[2], y0[3]); w.z = cvt_pk_bf16(y1[0], y1[1]); w.w = cvt_pk_bf16(y1[2], y1[3]); *(u32x4*)(xb + off + bj * HALF) = w;
                          sq += ((y0[0] * y0[0] + y0[1] * y0[1]) + (y0[2] * y0[2] + y0[3] * y0[3])) + ((y1[0] * y1[0] + y1[1] * y1[1]) + (y1[2] * y1[2] + y1[3] * y1[3])); } }
            if (xb) { sq += shx(sq, 16, lane); sq = half_sum(sq);
                      if (fq == 0) tab[((ai * 2 + wr) * 64 + m * 16 + fr) * 4 + wc] = sq; } };
        if (xin_f) {
            f32x4 ra[4], rb[4];
            auto ld = [&](int g, f32x4 (&r)[4]) { const size_t off = (size_t)(row0 + (g >> 2) * HALF + (g & 3) * 16) * ldc + col0;
#pragma unroll
                for (int q = 0; q < 4; ++q) r[q] = *(const f32x4*)(xin_f + off + (q >> 1) * HALF + (q & 1) * 4); };
            ld(0, ra);
#pragma unroll
            for (int g = 0; g < 8; g += 2) {
                ld(g + 1, rb); __builtin_amdgcn_sched_barrier(0); finish(g, ra); __builtin_amdgcn_sched_barrier(0);
                if (g + 2 < 8) ld(g + 2, ra); __builtin_amdgcn_sched_barrier(0); finish(g + 1, rb); __builtin_amdgcn_sched_barrier(0); }
        } else {
            u32x4 ra[2], rb[2];
            auto ld = [&](int g, u32x4 (&r)[2]) { const size_t off = (size_t)(row0 + (g >> 2) * HALF + (g & 3) * 16) * ldc + col0;
#pragma unroll
                for (int q = 0; q < 2; ++q) r[q] = *(const u32x4*)(xin_b + off + q * HALF); };
            auto cv = [&](const u32x4 (&r)[2], f32x4 (&x)[4]) {
#pragma unroll
                for (int q = 0; q < 2; ++q) { x[2 * q] = (f32x4){bflo(r[q].x), bfhi(r[q].x), bflo(r[q].y), bfhi(r[q].y)}; x[2 * q + 1] = (f32x4){bflo(r[q].z), bfhi(r[q].z), bflo(r[q].w), bfhi(r[q].w)}; } };
            ld(0, ra);
#pragma unroll
            for (int g = 0; g < 8; g += 2) { f32x4 x[4];
                ld(g + 1, rb); __builtin_amdgcn_sched_barrier(0); cv(ra, x); finish(g, x); __builtin_amdgcn_sched_barrier(0);
                if (g + 2 < 8) ld(g + 2, ra); __builtin_amdgcn_sched_barrier(0); cv(rb, x); finish(g + 1, x); __builtin_amdgcn_sched_barrier(0); }
        }
        if (xb) {
            asm volatile("s_waitcnt lgkmcnt(0)" ::: "memory"); __builtin_amdgcn_s_barrier(); asm volatile("" ::: "memory");
            if (fq == 0) {
#pragma unroll
                for (int ai = 0; ai < 2; ++ai) { const f32x4 t = *(const LAS f32x4*)(tab + ((ai * 2 + wr) * 64 + wc * 16 + fr) * 4);
                    ssq[(size_t)(u.pm * BM + wr * 64 + fr + ai * HALF + wc * 16) * 16 + u.pn] = (t[0] + t[1]) + (t[2] + t[3]); } }
        }
    }
};

template <class Epi, class Sched, bool ALIGN_EPI = false, bool SP2 = false>
__device__ __forceinline__ void gemm_phase(LAS unsigned char* lds, const Gemm g, const Sched& S, const Epi& E, int tid) {
    const int wid = __builtin_amdgcn_readfirstlane(tid >> 6), lane = tid & 63, wr = wid >> 2, wc = wid & 3, fr = lane & 15, fq = lane >> 4;
    const int K = g.ld, nt = g.K / BK;
    unsigned voffA[2], voffB[2];
#pragma unroll
    for (int i = 0; i < 2; ++i) { int R, C; stage_rc(tid * 16 + i * 8192, R, C); const int Rb = Epi::PERM ? ((R & ~31) + perm32(R & 31)) : R;
        voffA[i] = (unsigned)(R * K + C) * 2u; voffB[i] = (unsigned)(Rb * K + C) * 2u; }
    const size_t kstep = (size_t)(BK * 2);
    const size_t hstep = (size_t)HALF * K * 2;
    const size_t tstep = 2 * hstep;
    const unsigned ldsw = (unsigned)wid * 1024u;
    const int aoff = lds_byte(wr * 64 + fr, fq * 8), boff = lds_byte(wc * 32 + fr, fq * 8);
#define PG8_SA(b, h) (((b) * 2 + (h)) * HTB)
#define PG8_SB(b, h) ((4 + (b) * 2 + (h)) * HTB)
#define PG8_STAGE(bufoff, gbase, voff) do { _Pragma("unroll") for (int _i = 0; _i < 2; ++_i) \
        __builtin_amdgcn_global_load_lds((const unsigned*)((const char*)(gbase) + (voff)[_i]), (LAS unsigned*)(lds + (bufoff) + ldsw + _i * 8192), 16, 0, 0); } while (0)
#define PG8_LDA(dst, b, h) do { _Pragma("unroll") for (int m = 0; m < 4; ++m) _Pragma("unroll") for (int k = 0; k < 2; ++k) dst[m][k] = *(const LAS bf16x8*)(lds + PG8_SA(b, h) + aoff + m * 2048 + k * 1024); } while (0)
#define PG8_LDB(dst, b, h) do { _Pragma("unroll") for (int n = 0; n < 2; ++n) _Pragma("unroll") for (int k = 0; k < 2; ++k) dst[n][k] = *(const LAS bf16x8*)(lds + PG8_SB(b, h) + boff + n * 2048 + k * 1024); } while (0)
#define PG8_MMA(ai, bj, At, Bt) do { __builtin_amdgcn_s_setprio(1); _Pragma("unroll") for (int m = 0; m < 4; ++m) _Pragma("unroll") for (int n = 0; n < 2; ++n) _Pragma("unroll") for (int k = 0; k < 2; ++k) \
        acc[ai][bj][m][n] = __builtin_amdgcn_mfma_f32_16x16x32_bf16(Bt[n][k], At[m][k], acc[ai][bj][m][n], 0, 0, 0); __builtin_amdgcn_s_setprio(0); } while (0)
#define PG8_WAIT_V(n) asm volatile("s_waitcnt vmcnt(" #n ")" ::: "memory")
#define PG8_WAIT_L(n) asm volatile("s_waitcnt lgkmcnt(" #n ")" ::: "memory")
#define PG8_BAR __builtin_amdgcn_s_barrier()
#define PG8_SCHED __builtin_amdgcn_sched_barrier(0)
    Unit cur, nxt; int ui = 0;
    if (!S.next(0, cur)) return;
    f32x4 acc[2][2][4][2];
#pragma unroll
    for (int a = 0; a < 2; ++a)
#pragma unroll
        for (int b = 0; b < 2; ++b)
#pragma unroll
            for (int m = 0; m < 4; ++m)
#pragma unroll
                for (int n = 0; n < 2; ++n) acc[a][b][m][n] = (f32x4){0.f, 0.f, 0.f, 0.f};
    bf16x8 At[4][2], B0[2][2], B1[2][2];
    const char* cA = (const char*)g.A + S.offA(cur, tstep); const char* cB = (const char*)g.Bt + S.offB(cur, tstep);
    S.a_ready(cur);
    if constexpr (SP2) {
        PG8_STAGE(PG8_SB(0, 0), cB, voffB); PG8_STAGE(PG8_SB(0, 1), cB + hstep, voffB); PG8_STAGE(PG8_SA(0, 0), cA, voffA); PG8_STAGE(PG8_SA(0, 1), cA + hstep, voffA);
        if (wr == 1) PG8_BAR;
        PG8_WAIT_V(2); PG8_BAR;
        PG8_STAGE(PG8_SB(1, 0), cB + kstep, voffB); PG8_STAGE(PG8_SA(1, 0), cA + kstep, voffA); PG8_STAGE(PG8_SB(1, 1), cB + hstep + kstep, voffB);
        PG8_WAIT_V(6); PG8_BAR;
    } else {
        PG8_STAGE(PG8_SB(0, 0), cB, voffB); PG8_STAGE(PG8_SA(0, 0), cA, voffA); PG8_STAGE(PG8_SB(0, 1), cB + hstep, voffB); PG8_STAGE(PG8_SA(0, 1), cA + hstep, voffA);
        if (wr == 1) PG8_BAR;
        PG8_WAIT_V(4); PG8_BAR;
        PG8_STAGE(PG8_SB(1, 0), cB + kstep, voffB); PG8_STAGE(PG8_SA(1, 0), cA + kstep, voffA); PG8_STAGE(PG8_SB(1, 1), cB + hstep + kstep, voffB);
        PG8_WAIT_V(6); PG8_BAR;
    }
    for (;;) {
        const bool has_next = S.next(ui + 1, nxt);
        const char* nA = has_next ? (const char*)g.A + S.offA(nxt, tstep) : cA; const char* nB = has_next ? (const char*)g.Bt + S.offB(nxt, tstep) : cB;
        for (int t = 0; t < nt; t += 2) {
            const bool last = (t == nt - 2);
            const char* a1 = cA + (size_t)(t + 1) * kstep;
            const char* a2 = last ? nA : cA + (size_t)(t + 2) * kstep; const char* b2 = last ? nB : cB + (size_t)(t + 2) * kstep;
            const char* a3 = a2 + kstep; const char* b3 = b2 + kstep;
            if (last && has_next) S.a_ready(nxt);
            if constexpr (SP2) {
            PG8_LDB(B0, 0, 0); PG8_LDB(B1, 0, 1); PG8_SCHED; PG8_LDA(At, 0, 0); PG8_STAGE(PG8_SA(1, 1), a1 + hstep, voffA);
            PG8_WAIT_V(8); PG8_WAIT_L(0); PG8_BAR; PG8_MMA(0, 0, At, B0); PG8_MMA(0, 1, At, B1); PG8_BAR; PG8_SCHED;
            PG8_LDA(At, 0, 1); PG8_STAGE(PG8_SB(0, 0), b2, voffB); PG8_STAGE(PG8_SB(0, 1), b2 + hstep, voffB); PG8_STAGE(PG8_SA(0, 0), a2, voffA);
            PG8_WAIT_V(8); PG8_WAIT_L(0); PG8_BAR; PG8_MMA(1, 0, At, B0); PG8_MMA(1, 1, At, B1); PG8_BAR; PG8_SCHED;
            PG8_LDB(B0, 1, 0); PG8_LDB(B1, 1, 1); PG8_SCHED; PG8_LDA(At, 1, 0); PG8_STAGE(PG8_SA(0, 1), a2 + hstep, voffA);
            PG8_WAIT_V(8); PG8_WAIT_L(0); PG8_BAR; PG8_MMA(0, 0, At, B0); PG8_MMA(0, 1, At, B1); PG8_BAR; PG8_SCHED;
            PG8_LDA(At, 1, 1); PG8_STAGE(PG8_SB(1, 0), b3, voffB); PG8_STAGE(PG8_SB(1, 1), b3 + hstep, voffB); PG8_STAGE(PG8_SA(1, 0), a3, voffA);
            PG8_WAIT_V(8); PG8_WAIT_L(0); PG8_BAR; PG8_MMA(1, 0, At, B0); PG8_MMA(1, 1, At, B1); PG8_BAR; PG8_SCHED;
            } else {
            PG8_LDB(B0, 0, 0); PG8_SCHED; PG8_LDA(At, 0, 0); PG8_STAGE(PG8_SA(1, 1), a1 + hstep, voffA);
            PG8_WAIT_L(8); PG8_BAR; PG8_WAIT_L(0); PG8_MMA(0, 0, At, B0); PG8_BAR; PG8_SCHED;
            PG8_LDB(B1, 0, 1); PG8_STAGE(PG8_SB(0, 0), b2, voffB);
            PG8_BAR; PG8_WAIT_L(0); PG8_MMA(0, 1, At, B1); PG8_BAR;
            PG8_LDA(At, 0, 1); PG8_STAGE(PG8_SA(0, 0), a2, voffA);
            PG8_BAR; PG8_WAIT_L(0); PG8_MMA(1, 0, At, B0); PG8_BAR; PG8_SCHED;
            PG8_STAGE(PG8_SB(0, 1), b2 + hstep, voffB);
            PG8_WAIT_V(6); PG8_BAR; PG8_MMA(1, 1, At, B1); PG8_BAR;
            PG8_LDB(B0, 1, 0); PG8_SCHED; PG8_LDA(At, 1, 0); PG8_STAGE(PG8_SA(0, 1), a2 + hstep, voffA);
            PG8_WAIT_L(8); PG8_BAR; PG8_WAIT_L(0); PG8_MMA(0, 0, At, B0); PG8_BAR; PG8_SCHED;
            PG8_LDB(B1, 1, 1); PG8_STAGE(PG8_SB(1, 0), b3, voffB);
            PG8_BAR; PG8_WAIT_L(0); PG8_MMA(0, 1, At, B1); PG8_BAR;
            PG8_LDA(At, 1, 1); PG8_STAGE(PG8_SA(1, 0), a3, voffA);
            PG8_BAR; PG8_WAIT_L(0); PG8_MMA(1, 0, At, B0); PG8_BAR; PG8_SCHED;
            PG8_STAGE(PG8_SB(1, 1), b3 + hstep, voffB);
            PG8_WAIT_V(6); PG8_BAR; PG8_MMA(1, 1, At, B1); PG8_BAR;
            }
        }
        if constexpr (ALIGN_EPI) { if (wr == 0) PG8_BAR; }
        if constexpr (!Epi::AFTER_DRAIN) { E(acc, cur, wr, wc, fr, fq); S.done(cur); }
        if (!has_next) break;
#pragma unroll
        for (int a = 0; a < 2; ++a)
#pragma unroll
            for (int b = 0; b < 2; ++b)
#pragma unroll
                for (int m = 0; m < 4; ++m)
#pragma unroll
                    for (int n = 0; n < 2; ++n) acc[a][b][m][n] = (f32x4){0.f, 0.f, 0.f, 0.f};
        cur = nxt; cA = nA; cB = nB; ++ui;
        if constexpr (ALIGN_EPI) { if (wr == 1) PG8_BAR; }
    }
    PG8_WAIT_V(0);
    if constexpr (!ALIGN_EPI) { if (wr == 0) PG8_BAR; }
    PG8_BAR;
#undef PG8_SA
#undef PG8_SB
#undef PG8_STAGE
#undef PG8_LDA
#undef PG8_LDB
#undef PG8_MMA
#undef PG8_WAIT_V
#undef PG8_WAIT_L
#undef PG8_BAR
#undef PG8_SCHED
}
}

namespace att {
constexpr int D = 128, NW = 8, QBLK = 32, KVBLK = 64, QB = NW * QBLK;
constexpr int SHM_V = KVBLK * D * 2, SHM_K = KVBLK * D * 2;
constexpr int OFF_WS = 2 * SHM_V + 2 * SHM_K;
constexpr int OFF_BIAS = OFF_WS + NW * 64 * 4;
constexpr int OFF_QW = OFF_BIAS + NW * 2 * 64 * 4;
constexpr int ATT_LDS = OFF_QW + 16;
constexpr float SCALE = 0.08838834764831845f;
constexpr float THR2 = 8.f * 1.4426950408889634f;
constexpr int W = S_;
constexpr int LD = LDP;

#define KSWZ(row, colB) ((row) * 256 + ((colB) ^ (((row) & 7) << 4)))
#define SBAR() __builtin_amdgcn_sched_barrier(0)
__device__ __forceinline__ int v_st(int k, int c) { const int kk = (k & ~0xC) | ((k & 4) << 1) | ((k & 8) >> 1); return ((kk >> 3) * 4 + (c >> 5)) * 512 + ((kk & 7) * 32 + (c & 31)) * 2; }
__device__ __forceinline__ int v_rd_base(int lane) { return ((lane & 3) << 3) | (((lane >> 2) & 3) << 6) | (((lane >> 4) & 1) << 5) | (((lane >> 5) & 1) << 8); }
constexpr int v_rd_off(int d0, int ks, int half) { return d0 * 512 + ks * 4096 + half * 2048; }
__device__ __forceinline__ int crow(int r, int hi) { return (r & 3) + 8 * (r >> 2) + 4 * hi; }
__device__ __forceinline__ unsigned cvtpk(float lo, float hi) { unsigned r; asm volatile("v_cvt_pk_bf16_f32 %0, %1, %2" : "=v"(r) : "v"(lo), "v"(hi)); return r; }
__device__ __forceinline__ bf16x8 load8(const bf16* p) { return *reinterpret_cast<const bf16x8*>(p); }
__device__ __forceinline__ int fresh_lane() { int l; asm volatile("v_mbcnt_lo_u32_b32 %0, -1, 0\n\tv_mbcnt_hi_u32_b32 %0, -1, %0" : "=v"(l)); return l; }

__device__ __forceinline__ void mask_tile(f32x16& p0, f32x16& p1, int dq, unsigned Wu) {
    const float NEG = -__builtin_inff();
#pragma unroll
    for (int r = 0; r < 16; ++r) {
        const int c = (r & 3) + 8 * (r >> 2);
        if ((unsigned)(dq - c) >= Wu) p0[r] = NEG;
        if ((unsigned)(dq - c - 32) >= Wu) p1[r] = NEG;
    }
}
#define PK4(P, B_, OUT) do { unsigned a0 = cvt_pk_bf16(P[B_+0], P[B_+1]), a1 = cvt_pk_bf16(P[B_+2], P[B_+3]);                          \
        unsigned b0 = cvt_pk_bf16(P[B_+4], P[B_+5]), b1 = cvt_pk_bf16(P[B_+6], P[B_+7]);                                             \
        auto r0 = __builtin_amdgcn_permlane32_swap(a0, b0, false, false); auto r1 = __builtin_amdgcn_permlane32_swap(a1, b1, false, false); \
        u32x4 w = {r0[0], r1[0], r0[1], r1[1]}; OUT = *reinterpret_cast<bf16x8*>(&w); } while (0)
__device__ __forceinline__ void expA(f32x16& p0, float& ps, bf16x8& pa0, bf16x8& pa1) {
#pragma unroll
    for (int r = 0; r < 16; ++r) p0[r] = __builtin_amdgcn_exp2f(p0[r]);
    float t = 0;
#pragma unroll
    for (int r = 0; r < 16; ++r) t += p0[r];
    ps = t;
    PK4(p0, 0, pa0); PK4(p0, 8, pa1);
}
__device__ __forceinline__ void finishSM(f32x16& p1, float ps0, float& l_reg, bf16x8& pa2, bf16x8& pa3) {
#pragma unroll
    for (int r = 0; r < 16; ++r) p1[r] = __builtin_amdgcn_exp2f(p1[r]);
    float ps = ps0;
#pragma unroll
    for (int r = 0; r < 16; ++r) ps += p1[r];
    l_reg += ps;
    PK4(p1, 0, pa2); PK4(p1, 8, pa3);
}
}

namespace att2 {
using att::crow; using att::mask_tile; using att::expA; using att::finishSM; using att::fresh_lane; using att::load8;
constexpr int LD = LDP, QB = 256, KVBLK = 64, W = S_;
template <int NV> struct Lay { static constexpr int K_OFF = 0, V_OFF = 32768, V_BUF = NV * 16384, LI_OFF = V_OFF + 2 * V_BUF, BIAS_OFF = LI_OFF + 8 * 32 * 4, QW_OFF = BIAS_OFF + 8 * 128 * 4, ORD_OFF = QW_OFF + 16, QL_OFF = ORD_OFF + 128, BYTES = QL_OFF + 8 * 6144; };
struct Blk { const bf16* Q; const bf16* K; const bf16* V; const float* bias; int P0; int oc; int plane; int jlo; };

template <int NV, int KS0>
__device__ __forceinline__ void pv_half(f32x16* o, int vbase, const int (&kv)[4], bf16x8 qa, bf16x8 qb) {
    constexpr int G = NV * 4, U = 2 * G;
#define PV_RD(u, F) do { if constexpr ((u) < U) { asm volatile("ds_read_b128 %0, %1 offset:%2" : "=&v"(F) : "v"(vbase + kv[KS0 + (u) / G]), "i"(((u) % G) * 4096) : "memory"); } } while (0)
#define PV_WM(u, F) do { if constexpr ((u) < U) { constexpr int left_ = U - 1 - (u); constexpr int n_ = left_ < 3 ? left_ : 3;                                  \
        asm volatile("s_waitcnt lgkmcnt(%1)" : "+v"(F) : "i"(n_) : "memory");                                                                               \
        o[(u) % G] = __builtin_amdgcn_mfma_f32_32x32x16_bf16(((u) / G) ? qb : qa, F, o[(u) % G], 0, 0, 0); } } while (0)
    bf16x8 f0, f1, f2, f3;
    PV_RD(0, f0); PV_RD(1, f1); PV_RD(2, f2);
#define PV_Q(u) PV_RD((u) + 3, f3); PV_WM((u), f0); PV_RD((u) + 4, f0); PV_WM((u) + 1, f1); PV_RD((u) + 5, f1); PV_WM((u) + 2, f2); PV_RD((u) + 6, f2); PV_WM((u) + 3, f3);
    PV_Q(0) PV_Q(4)
    if constexpr (NV == 2) { PV_Q(8) PV_Q(12) }
#undef PV_Q
#undef PV_WM
#undef PV_RD
}
template <int KB, bool FOX>
__device__ __forceinline__ void qkt(f32x16& p0, f32x16& p1, const char* lds, int r32, int hi, const bf16x8* qr, const float* bl) {
    if (FOX) {
#pragma unroll
        for (int g = 0; g < 4; ++g) { const f32x4 b = *(const f32x4*)(bl + KB * 64 + 8 * g); p0[4 * g] = b[0]; p0[4 * g + 1] = b[1]; p0[4 * g + 2] = b[2]; p0[4 * g + 3] = b[3]; }
#pragma unroll
        for (int g = 0; g < 4; ++g) { const f32x4 b = *(const f32x4*)(bl + KB * 64 + 32 + 8 * g); p1[4 * g] = b[0]; p1[4 * g + 1] = b[1]; p1[4 * g + 2] = b[2]; p1[4 * g + 3] = b[3]; }
    } else { p0 = f32x16{}; p1 = f32x16{}; }
    const char* kb[4];
#pragma unroll
    for (int dd = 0; dd < 4; ++dd) kb[dd] = lds + KB * 16384 + KSWZ(r32, (dd * 16 + hi * 8) * 2);
#pragma unroll
    for (int d0 = 0; d0 < 8; ++d0) { const char* a = kb[d0 & 3] + (d0 >> 2) * 128;
        bf16x8 b0 = *reinterpret_cast<const bf16x8*>(a);
        bf16x8 b1 = *reinterpret_cast<const bf16x8*>(a + 32 * 256);
        p0 = __builtin_amdgcn_mfma_f32_32x32x16_bf16(b0, qr[d0], p0, 0, 0, 0);
        p1 = __builtin_amdgcn_mfma_f32_32x32x16_bf16(b1, qr[d0], p1, 0, 0, 0); }
}
#define MFMA16(a_, b_, c_) __builtin_amdgcn_mfma_f32_16x16x32_bf16(a_, b_, c_, 0, 0, 0)
template <int KB, bool FOX, int H>
__device__ __forceinline__ void qkt16(f32x4 (&p)[2][2], int ka0, const bf16x8 (&qr)[2][4], const float* bl) {
#pragma unroll
    for (int kbl = 0; kbl < 2; ++kbl) {
        f32x4 b0 = {0.f, 0.f, 0.f, 0.f};
        if (FOX) b0 = *(const f32x4*)(bl + KB * 64 + 32 * H + 16 * kbl);
        p[kbl][0] = b0; p[kbl][1] = b0; }
#define KQ_RD(n_, F) do { if constexpr ((n_) < 8) asm volatile("ds_read_b128 %0, %1 offset:%2" : "=&v"(F) : "v"(ka0 ^ (((n_) >> 1) * 64)), "i"(KB * 16384 + (2 * H + ((n_) & 1)) * 4096) : "memory"); } while (0)
#define KQ_MM(n_, F) do { constexpr int w_ = (7 - (n_)) < 3 ? (7 - (n_)) : 3;                                                                                  \
        asm volatile("s_waitcnt lgkmcnt(%1)" : "+v"(F) : "i"(w_) : "memory");                                                                                  \
        p[(n_) & 1][0] = MFMA16(F, qr[0][(n_) >> 1], p[(n_) & 1][0]); p[(n_) & 1][1] = MFMA16(F, qr[1][(n_) >> 1], p[(n_) & 1][1]); } while (0)
    bf16x8 f0, f1, f2, f3;
    KQ_RD(0, f0); KQ_RD(1, f1); KQ_RD(2, f2);
    KQ_RD(3, f3); KQ_MM(0, f0); KQ_RD(4, f0); KQ_MM(1, f1); KQ_RD(5, f1); KQ_MM(2, f2); KQ_RD(6, f2); KQ_MM(3, f3);
    KQ_RD(7, f3); KQ_MM(4, f0); KQ_MM(5, f1); KQ_MM(6, f2); KQ_MM(7, f3);
#undef KQ_RD
#undef KQ_MM
}
template <int KB>
__device__ __forceinline__ void kq_pref(int ka0, bf16x8& f0, bf16x8& f1, bf16x8& f2) {
    asm volatile("ds_read_b128 %0, %3 offset:%4\n\tds_read_b128 %1, %3 offset:%5\n\tds_read_b128 %2, %3 offset:%6" : "=&v"(f0), "=&v"(f1), "=&v"(f2) : "v"(ka0), "i"(KB * 16384), "i"(KB * 16384 + 4096), "i"(KB * 16384 + 8192) : "memory");
}
template <int KB, bool FOX>
__device__ __forceinline__ void qkt16f(f32x4 (&p0)[2][2], f32x4 (&p1)[2][2], int ka0, const bf16x8 (&qr)[2][4], const float* bl, bf16x8& f0, bf16x8& f1, bf16x8& f2) {
#pragma unroll
    for (int kbl = 0; kbl < 2; ++kbl) {
        f32x4 b0 = {0.f, 0.f, 0.f, 0.f}, b1 = {0.f, 0.f, 0.f, 0.f};
        if (FOX) { b0 = *(const f32x4*)(bl + KB * 64 + 16 * kbl); b1 = *(const f32x4*)(bl + KB * 64 + 32 + 16 * kbl); }
        p0[kbl][0] = b0; p0[kbl][1] = b0; p1[kbl][0] = b1; p1[kbl][1] = b1; }
#define KQ_RD(n_, F) do { if constexpr ((n_) < 16) asm volatile("ds_read_b128 %0, %1 offset:%2" : "=&v"(F) : "v"(ka0 ^ (((n_) >> 2) * 64)), "i"(KB * 16384 + ((n_) & 3) * 4096) : "memory"); } while (0)
#define KQ_MM(n_, F, P_, kl_) do { constexpr int w_ = (15 - (n_)) < 3 ? (15 - (n_)) : 3;                                                                         \
        asm volatile("s_waitcnt lgkmcnt(%1)" : "+v"(F) : "i"(w_) : "memory");                                                                                  \
        P_[kl_][0] = MFMA16(F, qr[0][(n_) >> 2], P_[kl_][0]); P_[kl_][1] = MFMA16(F, qr[1][(n_) >> 2], P_[kl_][1]); } while (0)
    bf16x8 f3;
#define KQ_Q(n_) KQ_RD((n_) + 3, f3); KQ_MM((n_), f0, p0, 0); KQ_RD((n_) + 4, f0); KQ_MM((n_) + 1, f1, p0, 1); KQ_RD((n_) + 5, f1); KQ_MM((n_) + 2, f2, p1, 0); KQ_RD((n_) + 6, f2); KQ_MM((n_) + 3, f3, p1, 1);
    KQ_Q(0) KQ_Q(4) KQ_Q(8) KQ_Q(12)
#undef KQ_Q
#undef KQ_RD
#undef KQ_MM
}
template <int H>
__device__ __forceinline__ void mask16(f32x4 (&p)[2][2], int dq) {
    const float NEG = -__builtin_inff();
#pragma unroll
    for (int kbl = 0; kbl < 2; ++kbl)
#pragma unroll
        for (int rbk = 0; rbk < 2; ++rbk)
#pragma unroll
            for (int r = 0; r < 4; ++r) { if (dq + 16 * rbk - 32 * H - 16 * kbl - r < 0) p[kbl][rbk][r] = NEG; }
}
__device__ __forceinline__ bf16x8 pack16(const f32x4& a, const f32x4& b) { u32x4 w = {cvt_pk_bf16(a[0], a[1]), cvt_pk_bf16(a[2], a[3]), cvt_pk_bf16(b[0], b[1]), cvt_pk_bf16(b[2], b[3])}; return *reinterpret_cast<bf16x8*>(&w); }
__device__ __forceinline__ void exp16(f32x4 (&p)[2][2], float (&ps)[2], bf16x8 (&pa)[2]) {
#pragma unroll
    for (int kbl = 0; kbl < 2; ++kbl)
#pragma unroll
        for (int rbk = 0; rbk < 2; ++rbk)
#pragma unroll
            for (int r = 0; r < 4; ++r) p[kbl][rbk][r] = __builtin_amdgcn_exp2f(p[kbl][rbk][r]);
#pragma unroll
    for (int rbk = 0; rbk < 2; ++rbk) { ps[rbk] += ((p[0][rbk][0] + p[0][rbk][1]) + (p[0][rbk][2] + p[0][rbk][3])) + ((p[1][rbk][0] + p[1][rbk][1]) + (p[1][rbk][2] + p[1][rbk][3]));
        pa[rbk] = pack16(p[0][rbk], p[1][rbk]); }
    asm volatile("" : "+v"(ps[0]), "+v"(ps[1]));
}
__device__ __forceinline__ void pv_pref(int vaddr, bf16x8& f0, bf16x8& f1, bf16x8& f2) {
    asm volatile("ds_read_b128 %0, %3\n\tds_read_b128 %1, %3 offset:2048\n\tds_read_b128 %2, %3 offset:4096" : "=&v"(f0), "=&v"(f1), "=&v"(f2) : "v"(vaddr) : "memory");
}
template <int NV>
__device__ __forceinline__ void pv16(f32x4 (&o)[2][NV * 8], int vaddr, const bf16x8 (&pa)[2], const bf16x8 (&pb)[2], bf16x8& f0, bf16x8& f1, bf16x8& f2) {
    constexpr int G = NV * 8, U = 2 * G;
#define PV_RD(u, F) do { if constexpr ((u) < U) { asm volatile("ds_read_b128 %0, %1 offset:%2" : "=&v"(F) : "v"(((u) / G) ? (vaddr ^ 64) : vaddr), "i"(((u) % G) * 2048) : "memory"); } } while (0)
#define PV_WM(u, F) do { if constexpr ((u) < U) { constexpr int left_ = U - 1 - (u); constexpr int n_ = left_ < 3 ? left_ : 3; constexpr int c_ = (u) % G;       \
        asm volatile("s_waitcnt lgkmcnt(%1)" : "+v"(F) : "i"(n_) : "memory");                                                                               \
        o[0][c_] = MFMA16(F, ((u) / G) ? pb[0] : pa[0], o[0][c_]); o[1][c_] = MFMA16(F, ((u) / G) ? pb[1] : pa[1], o[1][c_]); } } while (0)
    bf16x8 f3;
#define PV_Q(u) PV_RD((u) + 3, f3); PV_WM((u), f0); PV_RD((u) + 4, f0); PV_WM((u) + 1, f1); PV_RD((u) + 5, f1); PV_WM((u) + 2, f2); PV_RD((u) + 6, f2); PV_WM((u) + 3, f3);
    PV_Q(0) PV_Q(4) PV_Q(8) PV_Q(12)
    if constexpr (NV == 2) { PV_Q(16) PV_Q(20) PV_Q(24) PV_Q(28) }
#undef PV_Q
#undef PV_WM
#undef PV_RD
}
#define GLDS16(gp, lp) __builtin_amdgcn_global_load_lds((const unsigned*)(gp), (LAS unsigned*)(lp), 16, 0, 0)
#define A2_DMA(B_, k0, KB) do { const bf16* kg_ = (B_).K + (size_t)(k0) * LD; const bf16* vg_ = (B_).V + (k0);     \
        const u32x4 ot_ = ((volatile u32x4*)(lds + Lay<NV>::QL_OFF))[wid * 64 + fresh_lane()]; unsigned o0_ = ot_.x, o1_ = ot_.y, va_ = ot_.z, vb_ = ot_.w;     \
        GLDS16(kg_ + o0_, ldsl + (KB) * 16384 + wid * 2048); GLDS16(kg_ + o1_, ldsl + (KB) * 16384 + wid * 2048 + 1024);                          \
        GLDS16(vg_ + va_, ldsl + Lay<NV>::V_OFF + (KB) * Lay<NV>::V_BUF + wid * (NV * 2048)); GLDS16(vg_ + vb_, ldsl + Lay<NV>::V_OFF + (KB) * Lay<NV>::V_BUF + wid * (NV * 2048) + 1024);   \
        if constexpr (NV == 2) { GLDS16(vg_ + (size_t)16 * S_ + va_, ldsl + Lay<NV>::V_OFF + (KB) * Lay<NV>::V_BUF + wid * 4096 + 2048);          \
                                 GLDS16(vg_ + (size_t)16 * S_ + vb_, ldsl + Lay<NV>::V_OFF + (KB) * Lay<NV>::V_BUF + wid * 4096 + 3072); } } while (0)

template <int NV, bool FOX>
__device__ __forceinline__ void attn2_phase(const bf16* Pb, const bf16* VT, const float* dk, const int* jlo_tab, unsigned* qctr, bf16* abuf, float* opart, char* lds, LAS unsigned char* ldsl, int vcu, int G, int tid,
                                            float lam = 0.f, float post = 0.f, const float* sg = nullptr) {
    const int wid = __builtin_amdgcn_readfirstlane(tid >> 6), lane = tid & 63, r32 = lane & 31, hi = lane >> 5;
    volatile unsigned* qw = (volatile unsigned*)(lds + Lay<NV>::QW_OFF); volatile unsigned* ordt = (volatile unsigned*)(lds + Lay<NV>::ORD_OFF);
    constexpr int total = FOX ? 24 * 64 : 24 * 32;
    auto mk = [&](int L, int pass) -> Blk {
        Blk b;
        if (FOX) { const int it = L < total ? L : total - 1; const int qb = 63 - (it & 63), h = __builtin_amdgcn_readfirstlane((int)ordt[it >> 6]);
            b.P0 = qb * 256; b.jlo = jlo_tab[h * 64 + qb] & ~1;
            b.Q = Pb + (size_t)b.P0 * LD + QC + h * 128; b.K = Pb + KC + h * 128; b.V = VT + (size_t)(h * 128) * S_; b.bias = dk + (size_t)h * S_; b.oc = h * 128; b.plane = 0; }
        else { const int it3 = L >> 8, x8 = (L >> 5) & 7, xx = L & 31; const int qb = pass ? 63 - xx : xx;
               const int h = it3 < 2 ? x8 : (x8 < 4 ? 8 + x8 : 4 + x8), c = it3 < 2 ? it3 : (x8 < 4 ? 0 : 1);
            b.P0 = qb * 256; b.jlo = 0;
            b.Q = Pb + (size_t)b.P0 * LD + QC + c * 1536 + h * 128; b.K = Pb + KC + c * 1536 + h * 128; b.V = VT + (size_t)(h * 256) * S_; b.bias = nullptr; b.oc = h * 256; b.plane = c; }
        return b; };
    const int j16 = lane & 15, q4 = lane >> 4; (void)r32; (void)hi;
    float* B_w = (float*)(lds + Lay<NV>::BIAS_OFF) + wid * 128; const float* bl = B_w + 4 * q4;
    constexpr float RC2 = 1.f;
    float bst = 0.f;
    int L = vcu, Lnx = 0;
    if (FOX) {
        if (tid < 24) {
            const int mine = 256 - jlo_tab[tid * 64 + 63]; int rank = 0;
            for (int h2 = 0; h2 < 24; ++h2) { const int o2 = 256 - jlo_tab[h2 * 64 + 63]; rank += (o2 > mine || (o2 == mine && h2 < tid)) ? 1 : 0; }
            ordt[rank] = (unsigned)tid;
        }
        if (tid == 0) { qw[0] = __hip_atomic_fetch_add(qctr, 1u, __ATOMIC_RELAXED, __HIP_MEMORY_SCOPE_AGENT); qw[1] = __hip_atomic_fetch_add(qctr, 1u, __ATOMIC_RELAXED, __HIP_MEMORY_SCOPE_AGENT); }
        __syncthreads();
        L = __builtin_amdgcn_readfirstlane((int)qw[0]); Lnx = __builtin_amdgcn_readfirstlane((int)qw[1]);
        __syncthreads();
    }
    if (L >= total) return;
    const int lr = lane >> 4, lc = lane & 15, kr = (lane & 31) >> 2;
    const unsigned offK0 = (unsigned)((8 * wid + lr) * LD + ((lc ^ (8 * (wid & 1) + lr)) * 8)), offK1 = (unsigned)((8 * wid + 4 + lr) * LD + ((lc ^ (8 * (wid & 1) + 4 + lr)) * 8));
    const int vr8 = lane >> 3, vm = vr8 >> 1;
    const unsigned offVa = (unsigned)((wid * NV * 16 + vr8) * S_ + (((lane & 7) ^ vm) * 8)), offVb = (unsigned)((wid * NV * 16 + 8 + vr8) * S_ + (((lane & 7) ^ (4 + vm)) * 8));
    const int vb0 = (int)(uintptr_t)lds;
    { u32x4 t_ = {offK0, offK1, offVa, offVb}; ((u32x4*)(lds + Lay<NV>::QL_OFF))[wid * 64 + lane] = t_; }
    const int ka0 = vb0 + j16 * 256 + ((q4 ^ j16) * 16), va0 = vb0 + j16 * 128 + ((q4 ^ ((j16 >> 1) & 7)) * 16);
    int pass = 0; Blk cur = mk(L, 0);
    A2_DMA(cur, cur.jlo * KVBLK, 0);
    if (FOX) { const float d0_ = cur.bias[cur.P0 + wid * 32]; bst = cur.bias[cur.jlo * KVBLK + lane]; B_w[lane] = (bst - d0_) * RC2; }
    for (;;) {
        bool last; int passn = 0, Ln = L;
        if (FOX) { last = Lnx >= total;
            if (tid == 0) qw[0] = last ? (unsigned)total : __hip_atomic_fetch_add(qctr, 1u, __ATOMIC_RELAXED, __HIP_MEMORY_SCOPE_AGENT);
            Ln = Lnx; }
        else { const bool more_pass = pass == 0, more_item = L + G < total; last = !more_pass && !more_item;
            passn = pass + 1; if (!more_pass) { passn = 0; Ln = more_item ? L + G : L; } }
        const Blk nxt = last ? cur : mk(Ln, passn);
        const int NT = cur.P0 / KVBLK + 4 - cur.jlo;
        const bool desc = !FOX && pass != 0; const int NTn = nxt.P0 / KVBLK + 4 - nxt.jlo; const bool descn = !FOX && passn != 0;
#define TIX(i) (cur.jlo + (desc ? NT - 1 - (i) : (i)))
        const int qlo = cur.P0 + wid * 32, qm = qlo + j16 - 4 * q4;
        float dref = 0.f, dref_n = 0.f;
        if (FOX) { dref = cur.bias[qlo]; dref_n = nxt.bias[nxt.P0 + wid * 32]; }
        bf16x8 qr[2][4];
        { const int lq = fresh_lane(); const unsigned qoff = (unsigned)((wid * 32 + (lq & 15)) * LD + (lq >> 4) * 8);
#pragma unroll
          for (int rbk = 0; rbk < 2; ++rbk)
#pragma unroll
              for (int ks = 0; ks < 4; ++ks) qr[rbk][ks] = load8(cur.Q + qoff + rbk * 16 * LD + ks * 32); }
        float l2[2] = {0.f, 0.f}; f32x4 o[2][NV * 8];
#pragma unroll
        for (int rbk = 0; rbk < 2; ++rbk)
#pragma unroll
            for (int i = 0; i < NV * 8; ++i) o[rbk][i] = f32x4{0.f, 0.f, 0.f, 0.f};
        asm volatile("s_waitcnt vmcnt(0)" ::: "memory"); __syncthreads();
#define A2_STEP(t, KB, NEXT_DMA, BIAS_WR) do { bf16x8 pa[2], pb[2], kf0, kf1, kf2, vf0, vf1, vf2;                                         \
            int k0_ = ka0, v0_ = va0; asm volatile("" : "+v"(k0_), "+v"(v0_)); v0_ += Lay<NV>::V_OFF + KB * Lay<NV>::V_BUF;                 \
            kq_pref<KB>(k0_, kf0, kf1, kf2);                                                                                           \
            { const int kb_ = TIX(t) * KVBLK; const bool dg_ = kb_ + KVBLK - 1 > qlo; f32x4 p0[2][2], p1[2][2];                         \
              qkt16f<KB, FOX>(p0, p1, k0_, qr, bl, kf0, kf1, kf2);                                                                      \
              pv_pref(v0_, vf0, vf1, vf2);                                                                                             \
              NEXT_DMA;                                                                                                                \
              if (dg_) { mask16<0>(p0, qm - kb_); mask16<1>(p1, qm - kb_); }                                                            \
              exp16(p0, l2, pa); exp16(p1, l2, pb); }                                                                                  \
            __builtin_amdgcn_sched_barrier(0);                                                                                         \
            pv16<NV>(o, v0_, pa, pb, vf0, vf1, vf2);                                                                                   \
            asm volatile("s_waitcnt vmcnt(0)" ::: "memory"); BIAS_WR; __syncthreads(); } while (0)
        for (int t = 0; t < NT; t += 2) {
            A2_STEP(t, 0, do { A2_DMA(cur, TIX(t + 1) * KVBLK, 1); if (FOX) bst = cur.bias[TIX(t + 1) * KVBLK + lane]; } while (0),
                          do { if (FOX) B_w[64 + lane] = (bst - dref) * RC2; } while (0));
            A2_STEP(t + 1, 1, do { if (t + 2 < NT) { A2_DMA(cur, TIX(t + 2) * KVBLK, 0); if (FOX) bst = cur.bias[TIX(t + 2) * KVBLK + lane]; }
                                   else if (!last) { const int k0n_ = (nxt.jlo + (descn ? NTn - 1 : 0)) * KVBLK; A2_DMA(nxt, k0n_, 0); if (FOX) bst = nxt.bias[k0n_ + lane]; } } while (0),
                              do { if (FOX) B_w[lane] = (bst - ((t + 2 < NT) ? dref : dref_n)) * RC2; } while (0));
        }
#undef A2_STEP
#undef TIX
        const int le = fresh_lane(), je = le & 15, q4e = le >> 4;
        float rli[2];
#pragma unroll
        for (int rbk = 0; rbk < 2; ++rbk) { float l = l2[rbk]; l += shx(l, 16, le); l = half_sum(l); rli[rbk] = __builtin_amdgcn_rcpf(l); }
        if (FOX) {
#pragma unroll
            for (int rbk = 0; rbk < 2; ++rbk) { const int row = qlo + 16 * rbk + je;
                const bf16* gp = Pb + (size_t)row * LD + GC + cur.oc + 4 * q4e; bf16* op = abuf + (size_t)row * DM + cur.oc + 4 * q4e;
#pragma unroll
                for (int cb = 0; cb < NV * 8; ++cb) { const u32x2 g = *(const u32x2*)(gp + 16 * cb); const f32x4 v = o[rbk][cb] * rli[rbk];
                    u32x2 w; w.x = cvt_pk_bf16(v[0] * silu_f(bflo(g.x)), v[1] * silu_f(bfhi(g.x))); w.y = cvt_pk_bf16(v[2] * silu_f(bflo(g.y)), v[3] * silu_f(bfhi(g.y)));
                    *(u32x2*)(op + 16 * cb) = w; } }
        } else if (cur.oc < 8 * 256 && cur.plane == 1) {
#pragma unroll
          for (int rbk = 0; rbk < 2; ++rbk) { const int row = qlo + 16 * rbk + je;
              const bf16* pp = (const bf16*)opart + (size_t)row * MIXW + cur.oc + 4 * q4e; const bf16* gp = Pb + (size_t)row * LD + GC + cur.oc + 4 * q4e; bf16* op = abuf + (size_t)row * DM + cur.oc + 4 * q4e;
              float ss = 0.f;
#pragma unroll
              for (int cb = 0; cb < NV * 8; ++cb) { const unsigned long long a64 = __builtin_nontemporal_load((const unsigned long long*)(pp + 16 * cb)); const unsigned ax = (unsigned)a64, ay = (unsigned)(a64 >> 32);
                  const f32x4 o0 = {bflo(ax), bfhi(ax), bflo(ay), bfhi(ay)}; const f32x4 d = o0 - lam * (o[rbk][cb] * rli[rbk]); o[rbk][cb] = d;
                  ss += (d[0] * d[0] + d[1] * d[1]) + (d[2] * d[2] + d[3] * d[3]); }
              ss += shx(ss, 16, le); ss = half_sum(ss);
              const float rr = __builtin_amdgcn_rsqf(ss * (1.f / 256.f) + NORM_EPS) * post;
#pragma unroll
              for (int cb = 0; cb < NV * 8; ++cb) { const u32x2 g = *(const u32x2*)(gp + 16 * cb); const f32x4 sg4 = *(const f32x4*)(sg + 16 * cb + 4 * q4e); const f32x4 d = o[rbk][cb];
                  u32x2 w; w.x = cvt_pk_bf16(d[0] * rr * sg4[0] * silu_f(bflo(g.x)), d[1] * rr * sg4[1] * silu_f(bfhi(g.x))); w.y = cvt_pk_bf16(d[2] * rr * sg4[2] * silu_f(bflo(g.y)), d[3] * rr * sg4[3] * silu_f(bfhi(g.y)));
                  *(u32x2*)(op + 16 * cb) = w; } }
        } else {
#pragma unroll
          for (int rbk = 0; rbk < 2; ++rbk) { const int row = qlo + 16 * rbk + je;
              bf16* op = (bf16*)opart + (size_t)cur.plane * S_ * MIXW + (size_t)row * MIXW + cur.oc + 4 * q4e;
#pragma unroll
              for (int cb = 0; cb < NV * 8; ++cb) { const f32x4 v = o[rbk][cb] * rli[rbk]; u32x2 w; w.x = cvt_pk_bf16(v[0], v[1]); w.y = cvt_pk_bf16(v[2], v[3]); *(u32x2*)(op + 16 * cb) = w; } } }
        if (last) break;
        if (FOX) { const int inn = __builtin_amdgcn_readfirstlane((int)qw[0]); cur = nxt; L = Lnx; Lnx = inn; __syncthreads(); }
        else { cur = nxt; pass = passn; L = Ln; }
    }
    __syncthreads();
}

#undef GLDS16
#undef A2_DMA
}

#define XB_TMO      128
#define XB_XCNT(j)  (256  + 64 * (j))
#define XB_XSUB(j)  (1280 + 64 * (j))
#define XB_XGEN(j)  (2304 + 64 * (j))
#define XB_TOP      3328
#define XB_TOPGEN   3392
#define XCD_BAR_WORDS 3456
#define XB_SPIN_CAP (1u << 18)
__device__ __forceinline__ unsigned xb_ld(unsigned* p)              { return __hip_atomic_load(p, __ATOMIC_RELAXED, __HIP_MEMORY_SCOPE_AGENT); }
__device__ __forceinline__ unsigned xb_add(unsigned* p, unsigned v) { return __hip_atomic_fetch_add(p, v, __ATOMIC_RELAXED, __HIP_MEMORY_SCOPE_AGENT); }
__device__ __forceinline__ unsigned xb_xcc_id() { return (unsigned)__builtin_amdgcn_s_getreg((3 << 11) | 20) & 0xFu; }
#define XB_SPIN(cond, bar) do { unsigned _sp = 0; while (cond) { __builtin_amdgcn_s_sleep(1); \
    if ((++_sp & 255u) == 0u) { if (xb_ld(&(bar)[XB_TMO])) break; if (_sp > XB_SPIN_CAP) { atomicAdd(&(bar)[XB_TMO], 1u); break; } } } } while (0)
struct XcdBarrier { unsigned* bar; unsigned x; volatile LAS unsigned* st; };
__device__ __forceinline__ XcdBarrier xcd_barrier_post(unsigned* bar, volatile LAS unsigned* st) {
    XcdBarrier b; b.bar = bar; b.x = xb_xcc_id(); b.st = st;
    if (threadIdx.x == 0) (void)xb_add(&bar[XB_XCNT(b.x)], 1u);
    return b;
}
__device__ __forceinline__ void xcd_barrier_complete(unsigned* bar, unsigned x, unsigned& nloc, unsigned& nx) {
    const unsigned G = gridDim.x * gridDim.y * gridDim.z;
    unsigned sum, cnt, mine, sp = 0u;
    for (;;) {
        sum = 0u; cnt = 0u; mine = 0u;
#pragma unroll
        for (unsigned j = 0; j < 16; ++j) { const unsigned c = xb_ld(&bar[XB_XCNT(j)]); sum += c; cnt += (c > 0u) ? 1u : 0u; mine = (j == x) ? c : mine; }
        if (sum == G) break;
        __builtin_amdgcn_s_sleep(1);
        if ((++sp & 255u) == 0u) { if (xb_ld(&bar[XB_TMO])) break; if (sp > XB_SPIN_CAP) { atomicAdd(&bar[XB_TMO], 1u); break; } }
    }
    nloc = mine > 0u ? mine : 1u; nx = cnt > 0u ? cnt : 1u;
}
__device__ __forceinline__ void xcd_barrier(const XcdBarrier& b, bool thread0) {
    asm volatile("s_waitcnt vmcnt(0)" ::: "memory");
    __syncthreads();
    if (thread0) {
        unsigned* bar = b.bar;
        __builtin_amdgcn_s_waitcnt(0);
        unsigned nloc = b.st[0], nx = b.st[1];
        if (nloc == 0u) { xcd_barrier_complete(bar, b.x, nloc, nx); b.st[0] = nloc; b.st[1] = nx; }
        const unsigned old = xb_add(&bar[XB_XSUB(b.x)], 1u);
        const unsigned gen = old / nloc;
        if (old + 1u == (gen + 1u) * nloc) {
            __builtin_amdgcn_fence(__ATOMIC_RELEASE, "agent");
            asm volatile("s_waitcnt vmcnt(0)" ::: "memory");
            const unsigned og = xb_add(&bar[XB_TOP], 1u);
            const unsigned tg = og / nx;
            if (og + 1u == (tg + 1u) * nx) xb_add(&bar[XB_TOPGEN], 1u);
            else XB_SPIN(xb_ld(&bar[XB_TOPGEN]) == tg, bar);
            xb_add(&bar[XB_XGEN(b.x)], 1u);
            __builtin_amdgcn_fence(__ATOMIC_ACQUIRE, "agent");
            asm volatile("s_waitcnt vmcnt(0)" ::: "memory");
        } else {
            if (old == gen * nloc || old == gen * nloc + (nloc >> 1)) {
                __builtin_amdgcn_fence(__ATOMIC_RELEASE, "agent");
                asm volatile("s_waitcnt vmcnt(0)" ::: "memory");
            }
            XB_SPIN(xb_ld(&bar[XB_XGEN(b.x)]) == gen, bar);
            __builtin_amdgcn_fence(__ATOMIC_ACQUIRE, "agent");
            asm volatile("s_waitcnt vmcnt(0)" ::: "memory");
        }
    }
    __syncthreads();
}

__device__ __forceinline__ void tr_item(const float* W, int Nsrc, int c0, int nvalid, bf16* WT, int r0, LAS float* scr, int item, int nblk, int lane, const float* kgain = nullptr) {
    const int kb = item / nblk, nb = item - kb * nblk, k0 = 64 * kb, n0 = 32 * nb;
    const int nq = (lane & 7) * 4, kr = lane >> 3;
    const float* src = W + (size_t)(k0 + kr) * Nsrc + c0 + n0 + nq;
    f32x4 v[8];
    if (n0 + 32 <= nvalid) {
#pragma unroll
        for (int i = 0; i < 8; ++i) v[i] = *(const f32x4*)(src + (size_t)(8 * i) * Nsrc);
    } else {
#pragma unroll
        for (int i = 0; i < 8; ++i) { f32x4 t = {0.f, 0.f, 0.f, 0.f};
            if (n0 + nq + 0 < nvalid) t.x = src[(size_t)(8 * i) * Nsrc + 0]; if (n0 + nq + 1 < nvalid) t.y = src[(size_t)(8 * i) * Nsrc + 1];
            if (n0 + nq + 2 < nvalid) t.z = src[(size_t)(8 * i) * Nsrc + 2]; if (n0 + nq + 3 < nvalid) t.w = src[(size_t)(8 * i) * Nsrc + 3]; v[i] = t; }
    }
    if (kgain) {
#pragma unroll
        for (int i = 0; i < 8; ++i) v[i] = v[i] * kgain[k0 + 8 * i + kr];
    }
#pragma unroll
    for (int i = 0; i < 8; ++i) { LAS float* d = scr + (8 * i + kr) * 33 + nq; d[0] = v[i].x; d[1] = v[i].y; d[2] = v[i].z; d[3] = v[i].w; }
    LDS_WAIT(); asm volatile("" ::: "memory");
    const int c = lane & 7;
#pragma unroll
    for (int j = 0; j < 4; ++j) { const int n = (lane >> 3) + 8 * j; const LAS float* s = scr + (8 * c) * 33 + n;
        u32x4 o; o.x = cvt_pk_bf16(s[0 * 33], s[1 * 33]); o.y = cvt_pk_bf16(s[2 * 33], s[3 * 33]); o.z = cvt_pk_bf16(s[4 * 33], s[5 * 33]); o.w = cvt_pk_bf16(s[6 * 33], s[7 * 33]);
        *(u32x4*)(WT + (size_t)(r0 + n0 + n) * DM + k0 + 8 * c) = o; }
    LDS_WAIT(); asm volatile("" ::: "memory");
}
__device__ __forceinline__ void rms_row_to_bf16(const float* xrow, const float* g, bf16* orow, int lane) {
    const f32x4* xr = (const f32x4*)xrow + lane;
    f32x4 v[16]; float s = 0.f;
#pragma unroll
    for (int j = 0; j < 16; ++j) { v[j] = xr[64 * j]; s += (v[j].x * v[j].x + v[j].y * v[j].y) + (v[j].z * v[j].z + v[j].w * v[j].w); }
    const float rstd = __builtin_amdgcn_rsqf(wave_sum(s, lane) * (1.f / DM) + NORM_EPS);
    const f32x4* gr = (const f32x4*)g + lane;
    u32x2* o8 = (u32x2*)orow + lane;
#pragma unroll
    for (int j = 0; j < 16; ++j) { const f32x4 gg = gr[64 * j]; u32x2 w; w.x = cvt_pk_bf16(v[j].x * rstd * gg.x, v[j].y * rstd * gg.y); w.y = cvt_pk_bf16(v[j].z * rstd * gg.z, v[j].w * rstd * gg.w); o8[64 * j] = w; }
}

__device__ __forceinline__ void row_to_bf16_ssq(const float* xrow, bf16* orow, float* ssq, int lane) {
    const f32x4* xr = (const f32x4*)xrow + 2 * lane; u32x4* o16 = (u32x4*)orow + lane; float s = 0.f;
#pragma unroll
    for (int j = 0; j < 8; ++j) { const f32x4 v = xr[128 * j], u = xr[128 * j + 1];
        s += ((v.x * v.x + v.y * v.y) + (v.z * v.z + v.w * v.w)) + ((u.x * u.x + u.y * u.y) + (u.z * u.z + u.w * u.w));
        u32x4 w; w.x = cvt_pk_bf16(v.x, v.y); w.y = cvt_pk_bf16(v.z, v.w); w.z = cvt_pk_bf16(u.x, u.y); w.w = cvt_pk_bf16(u.z, u.w); o16[64 * j] = w; }
    s = wave_sum(s, lane);
    if (lane < 16) ssq[lane] = lane == 0 ? s : 0.f;
}

struct Args { const float* in[20]; float* out; unsigned char* ws; int ph_lo, ph_hi; };
typedef const __attribute__((address_space(4))) Args* ArgsP;
constexpr int N_PHASES = 3 + 6 * DEPTH;
constexpr int KV_SPLIT = 8;

#define MA_GLDS16(gp, lp) __builtin_amdgcn_global_load_lds((const unsigned*)(gp), (LAS unsigned*)(lp), 16, 0, 0)
__device__ __forceinline__ void mem_attn_wg(const bf16* P, const bf16* kmq, const bf16* vmt, bf16* abuf, int row0, int h, LAS unsigned char* ldsl, int wave, int lane) {
    const int r32 = lane & 31, hi = lane >> 5;
    const bf16* qbase = P + (size_t)row0 * LDP + MQC + h * 256;
    const unsigned qo = (unsigned)(r32 * LDP + hi * 8);
#pragma unroll
    for (int i = 0; i < 16; ++i) MA_GLDS16(kmq + (wave * 16 + i) * 512 + lane * 8, ldsl + (wave * 16 + i) * 1024);
    bf16x8 q[16];
#pragma unroll
    for (int ks = 0; ks < 8; ++ks) q[ks] = *(const bf16x8*)(qbase + qo + ks * 16);
    f32x16 s[8];
#pragma unroll
    for (int kb = 0; kb < 8; ++kb) s[kb] = f32x16{};
    float ss = 0.f;
    asm volatile("s_waitcnt vmcnt(0)" ::: "memory");
    __syncthreads();
    const LAS unsigned char* fl_ = ldsl + lane * 16;
#pragma unroll
    for (int ks = 0; ks < 16; ++ks) {
        if (ks + 8 < 16) q[ks + 8] = *(const bf16x8*)(qbase + qo + (ks + 8) * 16);
        bf16x8 kf[8];
#pragma unroll
        for (int kb = 0; kb < 8; ++kb) kf[kb] = *(const LAS bf16x8*)(fl_ + (kb * 16 + ks) * 1024);
#pragma unroll
        for (int jj = 0; jj < 8; ++jj) { const float v_ = bf2f((unsigned short)q[ks][jj]); ss += v_ * v_; }
#pragma unroll
        for (int kb = 0; kb < 8; ++kb) s[kb] = __builtin_amdgcn_mfma_f32_32x32x16_bf16(kf[kb], q[ks], s[kb], 0, 0, 0);
        __builtin_amdgcn_sched_barrier(0);
    }
    __syncthreads();
#pragma unroll
    for (int i = 0; i < 16; ++i) MA_GLDS16(vmt + (wave * 16 + i) * 512 + lane * 8, ldsl + (wave * 16 + i) * 1024);
    ss = half_sum(ss);
    const float rstd = __builtin_amdgcn_rsqf(ss * (1.f / 256.f) + NORM_EPS);
    const float cc = rstd * 0.0625f * LOG2E;
    float mx = s[0][0];
#pragma unroll
    for (int kb = 0; kb < 8; ++kb)
#pragma unroll
        for (int r = 0; r < 16; ++r) mx = fmaxf(mx, s[kb][r]);
    mx = half_max(mx);
    const float mL = -mx * cc; float l = 0.f;
    bf16x8 pa[16];
#pragma unroll
    for (int kb = 0; kb < 8; ++kb) {
#pragma unroll
        for (int r = 0; r < 16; ++r) { const float p = __builtin_amdgcn_exp2f(fmaf(s[kb][r], cc, mL)); s[kb][r] = p; l += p; }
        PK4(s[kb], 0, pa[2 * kb]); PK4(s[kb], 8, pa[2 * kb + 1]); }
    l = half_sum(l);
    const float linv = __builtin_amdgcn_rcpf(l);
    float rl[16];
#pragma unroll
    for (int r = 0; r < 16; ++r) rl[r] = shidx(linv, att::crow(r, hi));
    const bf16* gbase = P + (size_t)row0 * LDP + MGC + h * 256;
    bf16* obase = abuf + (size_t)row0 * DM + MIXW + h * 256;
    const unsigned go = (unsigned)(4 * hi * LDP + r32), ao = (unsigned)(4 * hi * DM + r32);
    asm volatile("s_waitcnt vmcnt(0)" ::: "memory");
    __syncthreads();
#pragma unroll 1
    for (int d0 = 0; d0 < 8; ++d0) { f32x16 o = f32x16{};
        unsigned short gv[16];
#pragma unroll
        for (int r = 0; r < 16; ++r) { const int cr = (r & 3) + 8 * (r >> 2); gv[r] = *(const unsigned short*)(gbase + (size_t)cr * LDP + go + d0 * 32); }
        bf16x8 vf[16];
#pragma unroll
        for (int ks = 0; ks < 16; ++ks) vf[ks] = *(const LAS bf16x8*)(fl_ + (d0 * 16 + ks) * 1024);
#pragma unroll
        for (int ks = 0; ks < 16; ++ks) o = __builtin_amdgcn_mfma_f32_32x32x16_bf16(pa[ks], vf[ks], o, 0, 0, 0);
#pragma unroll
        for (int r = 0; r < 16; ++r) { const int cr = (r & 3) + 8 * (r >> 2);
            const float v = o[r] * rl[r] * silu_f(bf2f(gv[r]));
            obase[(size_t)cr * DM + ao + d0 * 32] = (bf16)(cvt_pk_bf16(v, 0.f) & 0xffffu); } }
    __syncthreads();
}
#undef MA_GLDS16
__device__ __forceinline__ void fl_task(const bf16* h, const bf16* wfl, const float* ssqp, float* flb, int rowblk, LAS unsigned char* ldsl, int wave, int lane) {
    const int r32 = lane & 31, hi = lane >> 5, rb = wave & 1, kq = wave >> 1;
    const int row0 = rowblk * 64 + rb * 32;
    const bf16* ap = h + (size_t)(row0 + r32) * DM + kq * 1024 + hi * 8;
    const bf16* bp = wfl + (size_t)r32 * DM + kq * 1024 + hi * 8;
    f32x16 acc = f32x16{};
#pragma unroll 8
    for (int ks = 0; ks < 64; ++ks) { const bf16x8 a = *(const bf16x8*)(ap + ks * 16), b = *(const bf16x8*)(bp + ks * 16); acc = __builtin_amdgcn_mfma_f32_32x32x16_bf16(a, b, acc, 0, 0, 0); }
    LAS float* part = (LAS float*)ldsl;
#pragma unroll
    for (int r = 0; r < 16; ++r) part[((kq * 2 + rb) * 16 + r) * 64 + lane] = acc[r];
    __syncthreads();
    LAS float* outt = part + 4 * 2 * 16 * 64;
    if (kq == 0) {
        const float* sp = ssqp + (size_t)(row0 + r32) * 16;
        const f32x4 t0 = *(const f32x4*)sp, t1 = *(const f32x4*)(sp + 4), t2 = *(const f32x4*)(sp + 8), t3 = *(const f32x4*)(sp + 12);
        const float ssum = (((t0[0] + t0[1]) + (t0[2] + t0[3])) + ((t1[0] + t1[1]) + (t1[2] + t1[3]))) + (((t2[0] + t2[1]) + (t2[2] + t2[3])) + ((t3[0] + t3[1]) + (t3[2] + t3[3])));
        const float rstd = __builtin_amdgcn_rsqf(ssum * (1.f / DM) + NORM_EPS);
#pragma unroll
        for (int r = 0; r < 16; ++r) { const int cr = att::crow(r, hi);
            const float v = (part[((0 * 2 + rb) * 16 + r) * 64 + lane] + part[((1 * 2 + rb) * 16 + r) * 64 + lane]) + (part[((2 * 2 + rb) * 16 + r) * 64 + lane] + part[((3 * 2 + rb) * 16 + r) * 64 + lane]);
            outt[r32 * 64 + rb * 32 + cr] = v * shidx(rstd, cr); }
    }
    __syncthreads();
    { const int t = wave * 64 + lane, col = t >> 4, r4 = (t & 15) * 4;
      *(f32x4*)(flb + (size_t)col * S_ + (size_t)rowblk * 64 + r4) = *(const LAS f32x4*)(outt + col * 64 + r4); }
    __syncthreads();
}
#undef PK4

#define LAUNDER_TID() int lane; asm volatile("v_mbcnt_lo_u32_b32 %0, -1, 0\n\tv_mbcnt_hi_u32_b32 %0, -1, %0" : "=v"(lane)); const int wave = wave_s; \
                      const int tid = wave * 64 + lane; (void)tid
#define PHASE_BEGIN() ArgsP A = (ArgsP)__builtin_amdgcn_kernarg_segment_ptr(); asm volatile("" : "+s"(A)); LAUNDER_TID(); \
                      const int G = gridDim.x, bx = blockIdx.x; const int vcu = (G % 8 == 0) ? (bx % 8) * (G / 8) + bx / 8 : bx; \
                      const int NGW = G * 8, gw = vcu * 8 + wave; unsigned char* ws = A->ws; (void)NGW; (void)gw; (void)ws
#define WSP(T, off) ((T*)(ws + (off)))
__global__ void __launch_bounds__(512, 2) fwd(Args args) {
    extern __shared__ __attribute__((aligned(16))) unsigned char lds[];
    LAS unsigned char* ldsl = (LAS unsigned char*)lds;
    const int wave_s = __builtin_amdgcn_readfirstlane((int)threadIdx.x >> 6);
    { const int t0 = threadIdx.x; for (int u = t0; u < (LDS_BYTES - LDSCTL_OFF) / 4; u += 512) ((LAS unsigned*)(ldsl + LDSCTL_OFF))[u] = 0u; }
    __syncthreads();
    const int lo = args.ph_lo, hi_ph = args.ph_hi;
    if (hi_ph - lo > 1) { if (threadIdx.x == 0) (void)xb_add(&((unsigned*)(args.ws + WS_CTL) + CW_BAR)[XB_XCNT(xb_xcc_id())], 1u); }
    asm volatile("" ::: "memory");
#ifndef PH_MASK
#define PH_MASK 0x1ff
#endif
#define INK(kind, k) (((PH_MASK >> (kind)) & 1) && lo <= (k) && (k) < hi_ph)
#ifndef DUP_MASK
#define DUP_MASK 0
#endif
#define NREP(kind) (((DUP_MASK >> (kind)) & 1) ? 2 : 1)
#define SEAM(k) do { if (lo <= (k) && (k) + 1 < hi_ph) { PHASE_BEGIN(); XcdBarrier bar; bar.bar = (unsigned*)(ws + WS_CTL) + CW_BAR; bar.x = xb_xcc_id(); \
                     bar.st = (volatile LAS unsigned*)(ldsl + MISC_OFF) + 8; xcd_barrier(bar, tid == 0); } } while (0)

    if (INK(0, 0)) for (int rep = 0; rep < NREP(0); ++rep) {
        PHASE_BEGIN();
        const float* mem = A->in[1]; const float* mem_norm_g = A->in[2]; const float* w_out = A->in[4]; const float* w_mem_kv = A->in[5];
        const float* diff_w_in = A->in[8]; const float* fox_w_in = A->in[16];
        bf16* WinT = WSP(bf16, WS_WIN); bf16* WoutT = WSP(bf16, WS_WOUT); bf16* WkvT = WSP(bf16, WS_WKV); bf16* memn = WSP(bf16, WS_MEMN); float* rope = WSP(float, WS_ROPE);
        LAS float* scr = (LAS float*)(ldsl + wave * 16384);
        constexpr int I_DIFF = 64 * 448, I_FA = 64 * 384, I_FB = 64 * 64, I_FC = 64 * 8, I_FOX = I_FA + I_FB + I_FC, I_OUT = 64 * 128, I_KV = 64 * 64;
        constexpr int I_LAYER_D = I_DIFF + I_OUT + I_KV, I_LAYER_F = I_FOX + I_OUT + I_KV;
        constexpr int TOTAL = 2 * I_LAYER_D + 2 * I_LAYER_F;
        for (int it = gw; it < TOTAL; it += NGW) {
            int r = it; int l;
            if (r < I_LAYER_D) l = 0; else { r -= I_LAYER_D; if (r < I_LAYER_F) l = 1; else { r -= I_LAYER_F; if (r < I_LAYER_D) l = 2; else { r -= I_LAYER_D; l = 3; } } }
            const int j = l >> 1; const float* lng = A->in[3] + (size_t)l * DM;
            bf16* wt = WinT + (size_t)l * WROWS * DM;
            if ((l & 1) == 0) {
                if (r < I_DIFF) { tr_item(diff_w_in + (size_t)j * DM * DIFF_IN, DIFF_IN, 0, DIFF_IN, wt, 0, scr, r, 448, lane, lng); continue; } r -= I_DIFF;
            } else {
                const float* src = fox_w_in + (size_t)j * DM * FOX_IN;
                if (r < I_FA) { tr_item(src, FOX_IN, 0, 12288, wt, 0, scr, r, 384, lane, lng); continue; } r -= I_FA;
                if (r < I_FB) { tr_item(src, FOX_IN, 12312, 2048, wt, 12288, scr, r, 64, lane, lng); continue; } r -= I_FB;
                if (r < I_FC) { tr_item(src, FOX_IN, 12288, 24, wt, 14336, scr, r, 8, lane, lng); continue; } r -= I_FC;
            }
            if (r < I_OUT) { tr_item(w_out + (size_t)l * DM * DM, DM, 0, DM, WoutT + (size_t)l * DM * DM, 0, scr, r, 128, lane); continue; } r -= I_OUT;
            tr_item(w_mem_kv + (size_t)l * DM * 2048, 2048, 0, 2048, WkvT, l * 2048, scr, r, 64, lane);
        }
        for (int m = gw; m < NMEM; m += NGW) rms_row_to_bf16(mem + (size_t)m * DM, mem_norm_g, memn + (size_t)m * DM, lane);
        { const float* x0 = A->in[0]; bf16* xb = WSP(bf16, WS_H); float* ssq0 = WSP(float, WS_SSQP);
          for (int m = gw; m < S_; m += NGW) row_to_bf16_ssq(x0 + (size_t)m * DM, xb + (size_t)m * DM, ssq0 + (size_t)m * 16, lane); }
        for (int e = (vcu * 512 + tid); e < S_ * 16; e += G * 512) {
            const int s = e >> 4, i = e & 15;
            const float inv = (float)exp2(-(double)i * 1.1832230355827609);
            const float ang = (float)s * inv;
            double rev = (double)ang * 0.15915494309189535; rev -= floor(rev);
            const float rf = (float)rev;
            rope[(size_t)s * 32 + i] = __builtin_amdgcn_cosf(rf);
            rope[(size_t)s * 32 + 16 + i] = __builtin_amdgcn_sinf(rf);
        }
    }
    SEAM(0);
    if (INK(1, 1)) {
        PHASE_BEGIN();
        pg8::Gemm g{WSP(bf16, WS_MEMN), WSP(bf16, WS_WKV), NMEM * KV_SPLIT, 8192, DM / KV_SPLIT, DM}; pg8::SplitKOrder SO; SO.init(KV_SPLIT, 8192, DM / KV_SPLIT, G, bx);
        pg8::EpiF32 E{WSP(float, WS_OP), 8192};
        pg8::gemm_phase<pg8::EpiF32, pg8::SplitKOrder, true, true>(ldsl, g, SO, E, tid);
    }
    SEAM(1);

    for (int l = 0; l < DEPTH; ++l) {
        const int base = 3 + 6 * l, j = l >> 1; const bool fox = (l & 1) != 0;
        if (INK(4, base + 1)) for (int rep = 0; rep < NREP(4); ++rep) {
            PHASE_BEGIN();
            if (l == 0) {
            const float* mem_q_g = A->in[6]; const float* mem_k_g = A->in[7];
            const float* kvb = WSP(float, WS_OP); bf16* kmq = WSP(bf16, WS_KMQ); bf16* vmt = WSP(bf16, WS_VMT);
            for (int t = gw; t < 4 * 4 * NMEM; t += NGW) {
                const int key = t & 255, h = (t >> 8) & 3, l = t >> 10;
                const float* kr = kvb + (size_t)key * 8192 + l * 2048 + h * 256;
                f32x4 kx = *(const f32x4*)(kr + 4 * lane), vx = *(const f32x4*)(kr + 1024 + 4 * lane);
    #pragma unroll
                for (int sl = 1; sl < KV_SPLIT; ++sl) { kx += *(const f32x4*)(kr + (size_t)sl * NMEM * 8192 + 4 * lane); vx += *(const f32x4*)(kr + (size_t)sl * NMEM * 8192 + 1024 + 4 * lane); }
                const float ss = wave_sum((kx.x * kx.x + kx.y * kx.y) + (kx.z * kx.z + kx.w * kx.w), lane);
                const float rstd = __builtin_amdgcn_rsqf(ss * (1.f / 256.f) + NORM_EPS);
                const f32x4 gk = *(const f32x4*)(mem_k_g + l * 256 + 4 * lane), gq = *(const f32x4*)(mem_q_g + l * 256 + 4 * lane);
                u32x2 w; w.x = cvt_pk_bf16(kx.x * rstd * gk.x * gq.x, kx.y * rstd * gk.y * gq.y); w.y = cvt_pk_bf16(kx.z * rstd * gk.z * gq.z, kx.w * rstd * gk.w * gq.w);
                { const int d = 4 * lane;
                  *(u32x2*)(kmq + (size_t)(l * 4 + h) * 65536 + ((((key >> 5) * 16 + (d >> 4)) * 64 + ((d >> 3) & 1) * 32 + (key & 31)) * 8 + (d & 7))) = w; }
                bf16* vb = vmt + (size_t)(l * 4 + h) * 65536; const float vv[4] = {vx.x, vx.y, vx.z, vx.w};
    #pragma unroll
                for (int e = 0; e < 4; ++e) { const int d = 4 * lane + e;
                    vb[(((d >> 5) * 16 + (key >> 4)) * 64 + ((key >> 3) & 1) * 32 + (d & 31)) * 8 + (key & 7)] = (bf16)(cvt_pk_bf16(vv[e], 0.f) & 0xffffu); }
            }
            }
            const int N = DIFF_IN;
            if (fox) for (int rbk = 4 * (8 * (bx % 8) + ((bx / 8) % 8)) + (bx >> 6); rbk < S_ / 64; rbk += S_ / 64)
                fl_task(WSP(bf16, WS_H), WSP(bf16, WS_WIN) + ((size_t)l * WROWS + DIFF_IN) * DM, WSP(float, WS_SSQP) + (size_t)l * S_ * 16, WSP(float, WS_FL), rbk, ldsl, wave, lane);
            pg8::Gemm g{WSP(bf16, WS_H), WSP(bf16, WS_WIN) + (size_t)l * WROWS * DM, S_, N, DM, DM}; pg8::InprojOrder SO; SO.init(S_, N, G, bx);
            SO.dBA = (long)((const char*)g.Bt - (const char*)g.A); SO.v0 = V_PN0; SO.v1 = V_PN1;
            LAS float* rtab = (LAS float*)(ldsl + RING_BYTES + 8192);
            if (tid < 256) { const int pm0 = 8 * (bx % 8) + ((bx / 8) % 8); const float* sp = WSP(float, WS_SSQP) + ((size_t)l * S_ + (size_t)pm0 * 256 + tid) * 16;
                const f32x4 t0 = *(const f32x4*)sp, t1 = *(const f32x4*)(sp + 4), t2 = *(const f32x4*)(sp + 8), t3 = *(const f32x4*)(sp + 12);
                const float ssum = (((t0[0] + t0[1]) + (t0[2] + t0[3])) + ((t1[0] + t1[1]) + (t1[2] + t1[3]))) + (((t2[0] + t2[1]) + (t2[2] + t2[3])) + ((t3[0] + t3[1]) + (t3[2] + t3[3])));
                rtab[tid] = __builtin_amdgcn_rsqf(ssum * (1.f / DM) + NORM_EPS); }
            __syncthreads();
            pg8::EpiP E{WSP(bf16, WS_P), LDP, WSP(float, WS_FL), -1, WSP(float, WS_SSQP) + (size_t)l * S_ * 16,
                        (LAS float*)(ldsl + RING_BYTES), (fox ? A->in[18] : A->in[9]) + j * 128, (fox ? A->in[19] : A->in[10]) + j * 128, WSP(float, WS_ROPE), fox ? 0 : 1, WSP(bf16, WS_VT), rtab};
            pg8::gemm_phase<pg8::EpiP, pg8::InprojOrder, true, true>(ldsl, g, SO, E, tid);
        }
        SEAM(base + 1);
        if (INK(5, base + 2) && fox) {
            PHASE_BEGIN();
            bf16* Pb = WSP(bf16, WS_P);
#ifndef POST_PARTS
#define POST_PARTS 7
#endif
            if ((POST_PARTS & 1) && fox && vcu < 24) for (int rep = 0; rep < NREP(11); ++rep) {
                const int h = vcu; const float* flb = WSP(float, WS_FL); float* dk = WSP(float, WS_DK);
                const float bfv = A->in[17][j * 24 + h];
                float v[32]; float run = 0.f;
#pragma unroll
                for (int i = 0; i < 32; ++i) { const float z = flb[(size_t)h * S_ + tid * 32 + i] + bfv;
                    const float az = fabsf(z); const float lf = fminf(z, 0.f) - log1pf(__expf(-az)); run += lf; v[i] = run; }
                float inc = run;
#pragma unroll
                for (int o = 1; o < 64; o <<= 1) { const float t = shidx(inc, lane >= o ? lane - o : lane); if (lane >= o) inc += t; }
                LAS float* wt = (LAS float*)(ldsl + 1024);
                if (lane == 63) wt[wave] = inc;
                __syncthreads();
                float off = inc - run;
                for (int w = 0; w < wave; ++w) off += wt[w];
                float* dst = dk + (size_t)h * S_ + tid * 32;
#pragma unroll
                for (int i = 0; i < 32; i += 4) { f32x4 o4 = {-(off + v[i]) * LOG2E, -(off + v[i + 1]) * LOG2E, -(off + v[i + 2]) * LOG2E, -(off + v[i + 3]) * LOG2E}; *(f32x4*)(dst + i) = o4; }
                asm volatile("s_waitcnt vmcnt(0)" ::: "memory");
                __syncthreads();
                if (tid < 64) {
                    const float* qg_ = A->in[18] + j * 128; const float* kg_ = A->in[19] + j * 128; float mq = 0.f, mk_ = 0.f;
                    for (int i = 0; i < 128; ++i) { mq = fmaxf(mq, fabsf(qg_[i])); mk_ = fmaxf(mk_, fabsf(kg_[i])); }
                    const float B = 128.f * mq * mk_ * QSCALE * 1.02f, thr = 2.f * B + 40.f;
                    const int qb = tid; const float* dkh = dk + (size_t)h * S_;
                    const float ref = __builtin_nontemporal_load(dkh + 256 * qb) - thr;
                    int lo_ = 0, hi_ = 4 * qb;
                    while (lo_ < hi_) { const int mid = (lo_ + hi_) >> 1; if (__builtin_nontemporal_load(dkh + 64 * mid + 63) >= ref) hi_ = mid; else lo_ = mid + 1; }
                    WSP(int, WS_JLO)[h * 64 + qb] = lo_;
                }
                __syncthreads();
            }
            if (vcu >= 24) {
                const bf16* kmq = WSP(bf16, WS_KMQ); const bf16* vmt = WSP(bf16, WS_VMT); bf16* abuf = WSP(bf16, WS_A);
                for (int t = vcu; t < (S_ / 256) * 4; t += G) {
                    const int h = t & 3, row0 = (t >> 2) * 256 + wave * 32;
                    mem_attn_wg(Pb, kmq + (size_t)(l * 4 + h) * 65536, vmt + (size_t)(l * 4 + h) * 65536, abuf, row0, h, ldsl, wave, lane);
                }
            }
        }
        if (fox) SEAM(base + 2);
        if (INK(6, base + 3)) for (int rep = 0; rep < NREP(6); ++rep) {
            {
                PHASE_BEGIN();
                {
                    const bf16* Pb = WSP(bf16, WS_P); const bf16* kmq = WSP(bf16, WS_KMQ); const bf16* vmt = WSP(bf16, WS_VMT); bf16* abuf = WSP(bf16, WS_A);
                    if (!fox || vcu < 24) for (int t = vcu; t < (S_ / 256) * 4; t += G) {
                        const int h = t & 3, row0 = (t >> 2) * 256 + wave * 32;
                        mem_attn_wg(Pb, kmq + (size_t)(l * 4 + h) * 65536, vmt + (size_t)(l * 4 + h) * 65536, abuf, row0, h, ldsl, wave, lane);
                    }
                }
            }
            if (fox) { PHASE_BEGIN(); att2::attn2_phase<1, true>(WSP(bf16, WS_P), WSP(bf16, WS_VT), WSP(float, WS_DK), WSP(int, WS_JLO), (unsigned*)(ws + WS_CTL) + CW_QCTR + 64 * j, WSP(bf16, WS_A), WSP(float, WS_OP), (char*)lds, ldsl, vcu, G, tid); }
            else { PHASE_BEGIN();
                const float* lam_q1 = A->in[11]; const float* lam_k1 = A->in[12]; const float* lam_q2 = A->in[13]; const float* lam_k2 = A->in[14];
                const float lam_init = (l == 0) ? 0.2f : 0.4707130183435842f;
                float s1 = lam_q1[j * 128 + lane] * lam_k1[j * 128 + lane] + lam_q1[j * 128 + 64 + lane] * lam_k1[j * 128 + 64 + lane];
                float s2 = lam_q2[j * 128 + lane] * lam_k2[j * 128 + lane] + lam_q2[j * 128 + 64 + lane] * lam_k2[j * 128 + 64 + lane];
                s1 = wave_sum(s1, lane); s2 = wave_sum(s2, lane);
                const float lam = __expf(s1) - __expf(s2) + lam_init;
                att2::attn2_phase<2, false>(WSP(bf16, WS_P), WSP(bf16, WS_VT), WSP(float, WS_DK), WSP(int, WS_JLO), (unsigned*)(ws + WS_CTL) + CW_QCTR, WSP(bf16, WS_A), WSP(float, WS_OP), (char*)lds, ldsl, vcu, G, tid, __uint_as_float(__builtin_amdgcn_readfirstlane(__float_as_uint(lam))), 1.f - lam_init, A->in[15] + j * 256); }
        }
        SEAM(base + 3);
        if (INK(7, base + 4) && !fox) for (int rep = 0; rep < NREP(7); ++rep) {
            PHASE_BEGIN();
            const float* lam_q1 = A->in[11]; const float* lam_k1 = A->in[12]; const float* lam_q2 = A->in[13]; const float* lam_k2 = A->in[14]; const float* subln_g = A->in[15];
            const bf16* opart = WSP(bf16, WS_OP); const bf16* Pb = WSP(bf16, WS_P); bf16* abuf = WSP(bf16, WS_A);
            const float lam_init = (l == 0) ? 0.2f : 0.4707130183435842f;
            float s1 = lam_q1[j * 128 + lane] * lam_k1[j * 128 + lane] + lam_q1[j * 128 + 64 + lane] * lam_k1[j * 128 + 64 + lane];
            float s2 = lam_q2[j * 128 + lane] * lam_k2[j * 128 + lane] + lam_q2[j * 128 + 64 + lane] * lam_k2[j * 128 + 64 + lane];
            s1 = wave_sum(s1, lane); s2 = wave_sum(s2, lane);
            const float lam = __expf(s1) - __expf(s2) + lam_init;
            const f32x4 sg = *(const f32x4*)(subln_g + j * 256 + 4 * lane);
            const float post = 1.f - lam_init;
            const int l31 = lane & 31, hw = lane >> 5;
            const f32x4 sga = *(const f32x4*)(subln_g + j * 256 + 8 * l31), sgb = *(const f32x4*)(subln_g + j * 256 + 8 * l31 + 4);
            for (int t0 = gw; t0 < S_ * 4; t0 += 8 * NGW) {
                u32x4 a0[4], a1[4], gq[4];
#pragma unroll
                for (int u = 0; u < 4; ++u) { const int t = t0 + (2 * u + hw) * NGW, row = t >> 2, h = 8 + (t & 3); const size_t oo = (size_t)row * MIXW + h * 256 + 8 * l31;
                    a0[u] = *(const u32x4*)(opart + oo); a1[u] = *(const u32x4*)(opart + (size_t)S_ * MIXW + oo); gq[u] = *(const u32x4*)(Pb + (size_t)row * LDP + GC + h * 256 + 8 * l31); }
#pragma unroll
                for (int u = 0; u < 4; ++u) { const int t = t0 + (2 * u + hw) * NGW, row = t >> 2, h = 8 + (t & 3);
                    const f32x4 p0 = {bflo(a0[u].x), bfhi(a0[u].x), bflo(a0[u].y), bfhi(a0[u].y)}, p1 = {bflo(a0[u].z), bfhi(a0[u].z), bflo(a0[u].w), bfhi(a0[u].w)};
                    const f32x4 q0 = {bflo(a1[u].x), bfhi(a1[u].x), bflo(a1[u].y), bfhi(a1[u].y)}, q1 = {bflo(a1[u].z), bfhi(a1[u].z), bflo(a1[u].w), bfhi(a1[u].w)};
                    const f32x4 d0 = p0 - lam * q0, d1 = p1 - lam * q1;
                    float ss = ((d0.x * d0.x + d0.y * d0.y) + (d0.z * d0.z + d0.w * d0.w)) + ((d1.x * d1.x + d1.y * d1.y) + (d1.z * d1.z + d1.w * d1.w));
#pragma unroll
                    for (int o = 1; o < 32; o <<= 1) ss += shx(ss, o, lane);
                    const float r = __builtin_amdgcn_rsqf(ss * (1.f / 256.f) + NORM_EPS) * post;
                    u32x4 w; w.x = cvt_pk_bf16(d0.x * r * sga.x * silu_f(bflo(gq[u].x)), d0.y * r * sga.y * silu_f(bfhi(gq[u].x)));
                    w.y = cvt_pk_bf16(d0.z * r * sga.z * silu_f(bflo(gq[u].y)), d0.w * r * sga.w * silu_f(bfhi(gq[u].y)));
                    w.z = cvt_pk_bf16(d1.x * r * sgb.x * silu_f(bflo(gq[u].z)), d1.y * r * sgb.y * silu_f(bfhi(gq[u].z)));
                    w.w = cvt_pk_bf16(d1.z * r * sgb.z * silu_f(bflo(gq[u].w)), d1.w * r * sgb.w * silu_f(bfhi(gq[u].w)));
                    *(u32x4*)(abuf + (size_t)row * DM + h * 256 + 8 * l31) = w; }
            }
        }
        if (!fox) SEAM(base + 4);
        if (INK(8, base + 5)) {
            PHASE_BEGIN();
            pg8::Gemm g{WSP(bf16, WS_A), WSP(bf16, WS_WOUT) + (size_t)l * DM * DM, S_, DM, DM, DM}; pg8::StaticOrder SO; SO.init(S_, DM, G, bx);
            const bool lastl = l + 1 == DEPTH;
            pg8::EpiRes E{(l == 0) ? A->in[0] : (const float*)nullptr, WSP(bf16, WS_H), lastl ? A->out : (float*)nullptr, DM,
                          lastl ? (bf16*)nullptr : WSP(bf16, WS_H), WSP(float, WS_SSQP) + (size_t)(lastl ? 0 : l + 1) * S_ * 16, (LAS float*)(ldsl + RING_BYTES)};
            pg8::gemm_phase<pg8::EpiRes, pg8::StaticOrder, false, true>(ldsl, g, SO, E, tid);
        }
        if (l + 1 < DEPTH && MK_ONE_LAUNCH) {
            if (lo <= base + 5 && base + 6 < hi_ph) { PHASE_BEGIN();
                const int pm0 = 8 * (bx % 8) + ((bx / 8) % 8);
                unsigned* ctl = (unsigned*)(ws + WS_CTL); unsigned* qc = ctl + CW_QUAD + l * 64 + pm0;
                asm volatile("s_waitcnt vmcnt(0)" ::: "memory"); __syncthreads();
                if (tid == 0) {
                    __builtin_amdgcn_fence(__ATOMIC_RELEASE, "agent"); asm volatile("s_waitcnt vmcnt(0)" ::: "memory");
                    (void)xb_add(qc, 1u);
                    XB_SPIN(xb_ld(qc) < 4u, ctl + CW_BAR);
                    __builtin_amdgcn_fence(__ATOMIC_ACQUIRE, "agent"); asm volatile("s_waitcnt vmcnt(0)" ::: "memory"); }
                __syncthreads(); }
        } else SEAM(base + 5);
    }
#undef INK
#undef SEAM
}

extern "C" void kernel_launch(void* const* d_in, const int* in_sizes, int n_in, void* d_out, int out_size, void* d_ws, size_t ws_size, hipStream_t stream) {
    static int grid = 0;
    if (grid == 0) {
        if (n_in != 20 || out_size != S_ * DM || ws_size < WS_END) { fprintf(stderr, "kernel_launch: unexpected shapes (n_in %d out %d ws %zu need %zu)\n", n_in, out_size, ws_size, (size_t)WS_END); grid = -1; return; }
        int dev = 0, cus = 0;
        if (hipGetDevice(&dev) != hipSuccess || hipDeviceGetAttribute(&cus, hipDeviceAttributeMultiprocessorCount, dev) != hipSuccess) { grid = -1; return; }
        if (hipFuncSetAttribute((const void*)fwd, hipFuncAttributeMaxDynamicSharedMemorySize, LDS_BYTES) != hipSuccess) { fprintf(stderr, "kernel_launch: hipFuncSetAttribute failed\n"); grid = -1; return; }
        int per_cu = 0;
        (void)hipOccupancyMaxActiveBlocksPerMultiprocessor(&per_cu, (const void*)fwd, 512, LDS_BYTES);
        (void)hipGetLastError();
        grid = cus;
        if (grid > 256) grid = 256;
        if (grid != 256) { fprintf(stderr, "kernel_launch: this kernel is laid out for 256 CUs (found %d)\n", cus); grid = -1; return; }
    }
    if (grid < 0) return;
    (void)hipMemsetAsync((char*)d_ws + WS_CTL, 0, CTL_ZERO_BYTES, stream);
    Args a{};
    for (int i = 0; i < 20; ++i) a.in[i] = (const float*)d_in[i];
    a.out = (float*)d_out; a.ws = (unsigned char*)d_ws;
#if MK_ONE_LAUNCH
    a.ph_lo = 0; a.ph_hi = N_PHASES;
    hipLaunchKernelGGL(fwd, dim3(grid), dim3(512), LDS_BYTES, stream, a);
#else
    for (int p = 0; p < N_PHASES; ++p) {
        const int l = (p - 3) / 6, k = (p - 3) % 6;
        if (p >= 3 && k == 4 && (l & 1)) continue;
        a.ph_lo = p; a.ph_hi = p + 1;
        hipLaunchKernelGGL(fwd, dim3(grid), dim3(512), LDS_BYTES, stream, a);
    }
#endif
}
```
